# Optimizing an MI355X kernel written in HIP

```python
import jax, jax.numpy as jnp
from jax import lax
import numpy as np

D_MODEL = 2048
BATCH = 4
SEQ = 8192
DEPTH = 4
DEC_BATCH = 2
DEC_SEQ = 4096
PAST_LEN = 128

N_MIXERS = 2
N_LAYERS_A = (DEPTH + 1) // 2
N_LAYERS_B = DEPTH // 2

DIL_PATTERNS = ((128, 1), (512, 4), (2048, 16))
N_GROUPS_A = len(DIL_PATTERNS)
N_HEADS_A = 16
HEAD_DIM_A = 128
WIDTH_A = N_HEADS_A * HEAD_DIM_A
QKV_COLS_A = N_GROUPS_A * 3 * WIDTH_A

N_HEADS_B = 16
Q_LORA_RANK = 448
KV_LORA_RANK = 512
QK_NOPE_DIM = 128
QK_ROPE_DIM = 64
V_HEAD_DIM = 128
A_COLS_B = Q_LORA_RANK + KV_LORA_RANK + QK_ROPE_DIM
ROPE_BASE = 10000.0
Q_BLOCK = 128

D_FF = -(-8 * D_MODEL // (3 * 256)) * 256

NORM_EPS = 1e-6
NEG = -1e30

kernel_name = "hybrid_dilated_mla_encoder"


def rmsnorm(x, g):
    xf = x.astype(jnp.float32)
    y = xf * lax.rsqrt(jnp.mean(xf * xf, axis=-1, keepdims=True) + NORM_EPS)
    return (y * g.astype(jnp.float32)).astype(x.dtype)


def alibi_slopes(n_heads):
    return 2.0 ** (-8.0 * jnp.arange(1, n_heads + 1, dtype=jnp.float32) / n_heads)


def dilated_window_attention(q, k, v, slopes, dil, half):
    B, S, H, Dh = q.shape
    L = S // dil
    nblk = -(-L // half)
    Lp = nblk * half

    def by_residue(t):
        return t.reshape(B, L, dil, H, Dh).transpose(0, 2, 1, 3, 4)

    qs = jnp.pad(by_residue(q), ((0, 0), (0, 0), (0, Lp - L), (0, 0), (0, 0)))
    pad_kv = ((0, 0), (0, 0), (half, Lp - L + half), (0, 0), (0, 0))
    ks = jnp.pad(by_residue(k), pad_kv)
    vs = jnp.pad(by_residue(v), pad_kv)
    qb = qs.reshape(B, dil, nblk, half, H, Dh)

    def band(t):
        tb = t.reshape(B, dil, nblk + 2, half, H, Dh)
        return jnp.concatenate([tb[:, :, :-2], tb[:, :, 1:-1], tb[:, :, 2:]], axis=3)

    kb, vb = band(ks), band(vs)
    qpos = jnp.arange(Lp).reshape(nblk, half)
    kpos = jnp.arange(nblk)[:, None] * half + jnp.arange(3 * half)[None, :] - half
    rel = jnp.abs(kpos[:, None, :] - qpos[:, :, None])
    valid = (rel <= half) & (kpos[:, None, :] >= 0) & (kpos[:, None, :] < L)
    bias = -slopes[None, :, None, None] * (dil * rel).astype(jnp.float32)[:, None]
    s = jnp.einsum('bdnqhe,bdnkhe->bdnhqk', qb, kb).astype(jnp.float32) * (Dh ** -0.5) + bias
    s = jnp.where(valid[:, None], s, NEG)
    m = jnp.max(s, axis=-1)
    p = jnp.exp(s - m[..., None])
    l = jnp.sum(p, axis=-1)
    o = jnp.einsum('bdnhqk,bdnkhe->bdnqhe', p, vb.astype(jnp.float32))
    o = o / jnp.swapaxes(l, 3, 4)[..., None]
    lse = jnp.swapaxes(m + jnp.log(l), 3, 4)
    o = o.reshape(B, dil, Lp, H, Dh)[:, :, :L].transpose(0, 2, 1, 3, 4).reshape(B, S, H, Dh)
    lse = lse.reshape(B, dil, Lp, H)[:, :, :L].transpose(0, 2, 1, 3).reshape(B, S, H)
    return o, lse


def mixer_a(h, w_qkv, w_o):
    B, S, _ = h.shape
    qkv = (h @ w_qkv).reshape(B, S, N_GROUPS_A, 3, N_HEADS_A, HEAD_DIM_A)
    slopes = alibi_slopes(N_HEADS_A)
    outs, lses = [], []
    for g, (window, dil) in enumerate(DIL_PATTERNS):
        o, lse = dilated_window_attention(qkv[:, :, g, 0], qkv[:, :, g, 1], qkv[:, :, g, 2],
                                          slopes, dil, window // (2 * dil))
        outs.append(o)
        lses.append(lse)
    wts = jax.nn.softmax(jnp.stack(lses, axis=0), axis=0)
    o = jnp.sum(wts[..., None] * jnp.stack(outs, axis=0), axis=0)
    return o.reshape(B, S, WIDTH_A).astype(h.dtype) @ w_o


def apply_rope(t, cos, sin):
    half = t.shape[-1] // 2
    t1, t2 = t[..., :half], t[..., half:]
    c, s = cos.astype(t.dtype), sin.astype(t.dtype)
    return jnp.concatenate([t1 * c - t2 * s, t1 * s + t2 * c], axis=-1)


def mixer_b(h, w_a, g_q, g_kv, w_uq, w_ukv, w_o, cos, sin):
    B, S, _ = h.shape
    a = h @ w_a
    c_q = rmsnorm(a[..., :Q_LORA_RANK], g_q)
    c_kv = rmsnorm(a[..., Q_LORA_RANK:Q_LORA_RANK + KV_LORA_RANK], g_kv)
    k_r = apply_rope(a[..., Q_LORA_RANK + KV_LORA_RANK:], cos, sin)
    q = (c_q @ w_uq).reshape(B, S, N_HEADS_B, QK_NOPE_DIM + QK_ROPE_DIM)
    q_nope = q[..., :QK_NOPE_DIM]
    q_rope = apply_rope(q[..., QK_NOPE_DIM:], cos[:, None, :], sin[:, None, :])
    kv = (c_kv @ w_ukv).reshape(B, S, N_HEADS_B, QK_NOPE_DIM + V_HEAD_DIM)
    k_nope, v = kv[..., :QK_NOPE_DIM], kv[..., QK_NOPE_DIM:]
    nq = S // Q_BLOCK
    scale = (QK_NOPE_DIM + QK_ROPE_DIM) ** -0.5

    def blocks(t):
        return jnp.moveaxis(t.reshape(B, nq, Q_BLOCK, *t.shape[2:]), 1, 0)

    def attend(qs):
        qn, qr = qs
        s = (jnp.einsum('bqhd,bkhd->bhqk', qn, k_nope).astype(jnp.float32)
             + jnp.einsum('bqhr,bkr->bhqk', qr, k_r).astype(jnp.float32)) * scale
        p = jax.nn.softmax(s, axis=-1)
        return jnp.einsum('bhqk,bkhd->bqhd', p, v.astype(jnp.float32))

    o = lax.map(attend, (blocks(q_nope), blocks(q_rope)))
    o = jnp.moveaxis(o, 0, 1).reshape(B, S, N_HEADS_B * V_HEAD_DIM).astype(h.dtype)
    return o @ w_o


def swiglu(h, w_gate, w_up, w_down):
    return (jax.nn.silu(h @ w_gate) * (h @ w_up)) @ w_down


def rope_tables(S):
    inv_freq = 1.0 / (ROPE_BASE ** (jnp.arange(0, QK_ROPE_DIM, 2, dtype=jnp.float32) / QK_ROPE_DIM))
    ang = jnp.arange(S, dtype=jnp.float32)[:, None] * inv_freq[None, :]
    return jnp.cos(ang), jnp.sin(ang)


def trunk(x, norm_mix, norm_ffn, norm_final, a_w_qkv, a_w_o, b_w_a, b_g_q, b_g_kv,
          b_w_uq, b_w_ukv, b_w_o, ffn_w_gate, ffn_w_up, ffn_w_down):
    cos, sin = rope_tables(x.shape[1])
    for i in range(DEPTH):
        h = rmsnorm(x, norm_mix[i])
        j = i // N_MIXERS
        if i % N_MIXERS == 0:
            x = x + mixer_a(h, a_w_qkv[j], a_w_o[j])
        else:
            x = x + mixer_b(h, b_w_a[j], b_g_q[j], b_g_kv[j], b_w_uq[j], b_w_ukv[j], b_w_o[j], cos, sin)
        h = rmsnorm(x, norm_ffn[i])
        x = x + swiglu(h, ffn_w_gate[i], ffn_w_up[i], ffn_w_down[i])
    return rmsnorm(x, norm_final)


def setup_inputs(seed: int = 0) -> dict:
    key = jax.random.key(seed)
    ks = jax.random.split(key, 18)

    def w(k, shape, fan_in):
        return jax.random.normal(k, shape, jnp.float32) * (fan_in ** -0.5)

    def gain(k, shape):
        return 1.0 + 0.05 * jax.random.normal(k, shape, jnp.float32)

    return {
        "x_prompt": jax.random.normal(ks[0], (BATCH, SEQ, D_MODEL), jnp.float32),
        "x_sample": jax.random.normal(ks[1], (DEC_BATCH, DEC_SEQ, D_MODEL), jnp.float32),
        "norm_mix": gain(ks[2], (DEPTH, D_MODEL)),
        "norm_ffn": gain(ks[3], (DEPTH, D_MODEL)),
        "norm_final": gain(ks[4], (D_MODEL,)),
        "a_w_qkv": w(ks[5], (N_LAYERS_A, D_MODEL, QKV_COLS_A), D_MODEL),
        "a_w_o": w(ks[6], (N_LAYERS_A, WIDTH_A, D_MODEL), WIDTH_A),
        "b_w_a": w(ks[7], (N_LAYERS_B, D_MODEL, A_COLS_B), D_MODEL),
        "b_g_q": gain(ks[8], (N_LAYERS_B, Q_LORA_RANK)),
        "b_g_kv": gain(ks[9], (N_LAYERS_B, KV_LORA_RANK)),
        "b_w_uq": w(ks[10], (N_LAYERS_B, Q_LORA_RANK, N_HEADS_B * (QK_NOPE_DIM + QK_ROPE_DIM)), Q_LORA_RANK),
        "b_w_ukv": w(ks[11], (N_LAYERS_B, KV_LORA_RANK, N_HEADS_B * (QK_NOPE_DIM + V_HEAD_DIM)), KV_LORA_RANK),
        "b_w_o": w(ks[12], (N_LAYERS_B, N_HEADS_B * V_HEAD_DIM, D_MODEL), N_HEADS_B * V_HEAD_DIM),
        "ffn_w_gate": w(ks[13], (DEPTH, D_MODEL, D_FF), D_MODEL),
        "ffn_w_up": w(ks[14], (DEPTH, D_MODEL, D_FF), D_MODEL),
        "ffn_w_down": w(ks[15], (DEPTH, D_FF, D_MODEL), D_FF),
    }


def reference(x_prompt, x_sample, norm_mix, norm_ffn, norm_final, a_w_qkv, a_w_o, b_w_a, b_g_q,
              b_g_kv, b_w_uq, b_w_ukv, b_w_o, ffn_w_gate, ffn_w_up, ffn_w_down):
    y_prompt = trunk(x_prompt, norm_mix, norm_ffn, norm_final, a_w_qkv, a_w_o, b_w_a, b_g_q, b_g_kv,
                     b_w_uq, b_w_ukv, b_w_o, ffn_w_gate, ffn_w_up, ffn_w_down)
    y_sample = trunk(x_sample, norm_mix, norm_ffn, norm_final, a_w_qkv, a_w_o, b_w_a, b_g_q, b_g_kv,
                     b_w_uq, b_w_ukv, b_w_o, ffn_w_gate, ffn_w_up, ffn_w_down)
    return (y_prompt, y_sample)
```

```cpp
#include <hip/hip_runtime.h>
#include <cstdio>
#include <cstdint>
#ifndef REP_FFN
#define REP_FFN 1
#endif
#ifndef REP_MLA
#define REP_MLA 1
#endif
#ifndef REP_THIN
#define REP_THIN 1
#endif
#ifndef REP_DWA
#define REP_DWA 1
#endif
#ifndef REP_QKV
#define REP_QKV 1
#endif

#define LAS __attribute__((address_space(3)))
#define GAS __attribute__((address_space(1)))
typedef unsigned short bf16_t;
typedef short bf16x8 __attribute__((ext_vector_type(8)));
typedef short s16x4 __attribute__((ext_vector_type(4)));
typedef float f32x4 __attribute__((ext_vector_type(4)));
typedef float f32x2 __attribute__((ext_vector_type(2)));
typedef float f32x16 __attribute__((ext_vector_type(16)));
typedef unsigned u32x4 __attribute__((ext_vector_type(4)));
typedef unsigned u32x2 __attribute__((ext_vector_type(2)));
typedef GAS unsigned gu32;

constexpr int DM = 2048, T_ALL = 40960, T_PROMPT = 32768, SEQ_P = 8192, SEQ_S = 4096;
constexpr int DFF = 5632, NQKV = 18432, NA = 1024, QLR = 448, QLP = 512, KVL = 512, NQ = 3072, NKV = 4096, NH = 16;
constexpr int CHUNK = 8192, NCHUNK = 5;
constexpr float NORM_EPS = 1e-6f;
constexpr float LOG2E = 1.4426950408889634f;

__device__ __forceinline__ int fresh_lane() { int l; asm volatile("v_mbcnt_lo_u32_b32 %0, -1, 0\n\tv_mbcnt_hi_u32_b32 %0, -1, %0" : "=v"(l)); return l; }
__device__ __forceinline__ unsigned cvt_pk_bf16(float lo, float hi) { unsigned r; asm volatile("v_cvt_pk_bf16_f32 %0, %1, %2" : "=v"(r) : "v"(lo), "v"(hi)); return r; }
__device__ __forceinline__ int row_pos(int row) { return row < T_PROMPT ? (row & (SEQ_P - 1)) : (row & (SEQ_S - 1)); }

namespace pg8 {
constexpr int BM = 256, BK = 64, HALF = 128, HTB = HALF * BK * 2, STAGE_BYTES = 8 * HTB, NXCD = 8, WGM = 8;
__host__ __device__ __forceinline__ int lds_byte(int r, int c) { const int st = (r >> 4) * 2 + (c >> 5), rr = r & 15, cc = c & 31, ob = rr * 64 + cc * 2; return st * 1024 + (ob ^ (((ob >> 9) & 1) << 5)); }
__host__ __device__ __forceinline__ void stage_rc(int b, int& R, int& C) { const int st = b / 1024, sb = b % 1024, swz = sb ^ (((sb >> 9) & 1) << 5); R = (st >> 1) * 16 + swz / 64; C = (st & 1) * 32 + (swz % 64) / 2; }
__host__ __device__ __forceinline__ int perm32(int rho) { const int n = rho >> 4, i = rho & 15; return 8 * (i >> 2) + 4 * n + (i & 3); }

struct Unit { int pm, pn; };
struct Gemm { const bf16_t* A; const bf16_t* Bt; int M, N, K; };

struct StaticOrder {
    int nM, nN, nwg, G, c;
    __host__ __device__ void init(int M, int N, int G_, int c_) { nM = M / BM; nN = N / BM; nwg = nM * nN; G = G_; c = c_; }
    __host__ __device__ bool next(int i, Unit& u) const {
        const long L = (long)i * G + c; if (L >= nwg) return false;
        int wgid = (int)L; { const int q = nwg / NXCD, r = nwg % NXCD, xcd = wgid % NXCD, off = wgid / NXCD; wgid = (xcd < r ? xcd * (q + 1) : r * (q + 1) + (xcd - r) * q) + off; }
        const int nig = WGM * nN, gid = wgid / nig, fm = gid * WGM, gsz = (nM - fm) < WGM ? (nM - fm) : WGM;
        u.pm = fm + ((wgid % nig) % gsz); u.pn = (wgid % nig) / gsz; return true;
    }
    __device__ __forceinline__ void a_ready(const Unit&) const {}
    __device__ __forceinline__ void done(const Unit&) const {}
};

typedef unsigned long long u64;
constexpr float SS_SCALE = 1048576.0f, SS_INV = 1.0f / 1048576.0f;
__device__ __forceinline__ float row_rstd(const u64* ss, int row) { return ss ? __builtin_amdgcn_rsqf((float)ss[row] * (SS_INV / DM) + NORM_EPS) : 1.0f; }
struct EpiBf16 {
    static constexpr bool PERM = true, AFTER_DRAIN = false;
    bf16_t* O; int ldc; int sect_rows; const u64* ss;
    __device__ __forceinline__ void operator()(const f32x4 (&acc)[2][2][4][2], const Unit& u, int wr, int wc, int fr, int fq) const {
        const int row0 = u.pm * BM + wr * 64 + fr, col0 = u.pn * BM + wc * 32 + 8 * fq;
#pragma unroll
        for (int ai = 0; ai < 2; ++ai)
#pragma unroll
            for (int m = 0; m < 4; ++m) { const int row = row0 + ai * HALF + m * 16; const float rs = row_rstd(ss, row);
#pragma unroll
                for (int bj = 0; bj < 2; ++bj) { const f32x4 v0 = acc[ai][bj][m][0] * rs, v1 = acc[ai][bj][m][1] * rs;
                    bf16_t* p = sect_rows ? O + ((size_t)(2 * u.pn + bj) * sect_rows + row) * 128 + wc * 32 + 8 * fq : O + (size_t)row * ldc + col0 + bj * HALF;
                    u32x4 w; w.x = cvt_pk_bf16(v0[0], v0[1]); w.y = cvt_pk_bf16(v0[2], v0[3]); w.z = cvt_pk_bf16(v1[0], v1[1]); w.w = cvt_pk_bf16(v1[2], v1[3]);
                    *(u32x4*)p = w; } }
    }
};
struct EpiQRope {
    static constexpr bool PERM = true, AFTER_DRAIN = false;
    bf16_t* O; int ldc; const float* tabc; const float* tabs; int row_base;
    __device__ __forceinline__ void operator()(const f32x4 (&acc)[2][2][4][2], const Unit& u, int wr, int wc, int fr, int fq) const {
        const int row0 = u.pm * BM + wr * 64 + fr, col0 = u.pn * BM + wc * 32 + 8 * fq;
#pragma unroll
        for (int bj = 0; bj < 2; ++bj) {
            const int G = u.pn * 8 + bj * 4 + wc, within = G % 6;
            const bool rope = within >= 4; const int j0 = 16 * (within - 4) + 4 * fq;
#pragma unroll
            for (int ai = 0; ai < 2; ++ai)
#pragma unroll
                for (int m = 0; m < 4; ++m) { const int row = row0 + ai * HALF + m * 16; bf16_t* rowp = O + (size_t)row * ldc + col0 + bj * HALF;
                    f32x4 v0 = acc[ai][bj][m][0], v1 = acc[ai][bj][m][1];
                    if (rope) { const int pos = row_pos(row_base + row); const f32x4 c = *(const f32x4*)(tabc + pos * 32 + j0), s = *(const f32x4*)(tabs + pos * 32 + j0);
                        const f32x4 o1 = v0 * c - v1 * s, o2 = v0 * s + v1 * c; v0 = o1; v1 = o2; }
                    u32x4 w; w.x = cvt_pk_bf16(v0[0], v0[1]); w.y = cvt_pk_bf16(v0[2], v0[3]); w.z = cvt_pk_bf16(v1[0], v1[1]); w.w = cvt_pk_bf16(v1[2], v1[3]);
                    *(u32x4*)rowp = w; }
        }
    }
};
struct EpiSwiGLU {
    static constexpr bool PERM = true, AFTER_DRAIN = false;
    bf16_t* O; int ldc; const u64* ss;
    __device__ __forceinline__ void operator()(const f32x4 (&acc)[2][2][4][2], const Unit& u, int wr, int wc, int fr, int fq) const {
        const int row0 = u.pm * BM + wr * 64 + fr, col0 = u.pn * HALF + wc * 32 + 8 * fq;
#pragma unroll
        for (int ai = 0; ai < 2; ++ai)
#pragma unroll
            for (int m = 0; m < 4; ++m) { const int row = row0 + ai * HALF + m * 16; bf16_t* rowp = O + (size_t)row * ldc + col0; float r[8]; const float rs = row_rstd(ss, row);
#pragma unroll
                for (int n = 0; n < 2; ++n)
#pragma unroll
                    for (int e = 0; e < 4; ++e) { const float g = acc[ai][0][m][n][e] * rs, up = acc[ai][1][m][n][e] * rs;
                        const float sg = g * __builtin_amdgcn_rcpf(1.0f + __builtin_amdgcn_exp2f(-g * LOG2E)); r[n * 4 + e] = sg * up; }
                u32x4 w; w.x = cvt_pk_bf16(r[0], r[1]); w.y = cvt_pk_bf16(r[2], r[3]); w.z = cvt_pk_bf16(r[4], r[5]); w.w = cvt_pk_bf16(r[6], r[7]);
                *(u32x4*)rowp = w; }
    }
};
struct EpiRes {
    static constexpr bool PERM = false, AFTER_DRAIN = false;
    float* out; int ldc; bf16_t* xg; const float* gain; u64* ss;
    __device__ __forceinline__ void operator()(const f32x4 (&acc)[2][2][4][2], const Unit& u, int wr, int wc, int fr, int fq) const {
        const int col0 = u.pn * BM + wc * 32 + 4 * fq, lane = fq * 16 + fr;
        f32x4 g4[2][2];
#pragma unroll
        for (int bj = 0; bj < 2; ++bj)
#pragma unroll
            for (int n = 0; n < 2; ++n) g4[bj][n] = xg ? *(const f32x4*)(gain + col0 + bj * HALF + n * 16) : (f32x4){0.f, 0.f, 0.f, 0.f};
#pragma unroll
        for (int ai = 0; ai < 2; ++ai)
#pragma unroll
            for (int m = 0; m < 4; ++m) { const int row = u.pm * BM + ai * HALF + wr * 64 + m * 16 + fr; float* rowp = out + (size_t)row * ldc + col0;
                f32x4 b[2][2];
#pragma unroll
                for (int bj = 0; bj < 2; ++bj)
#pragma unroll
                    for (int n = 0; n < 2; ++n) b[bj][n] = *(const f32x4*)(rowp + bj * HALF + n * 16);
                float q = 0.f;
#pragma unroll
                for (int bj = 0; bj < 2; ++bj)
#pragma unroll
                    for (int n = 0; n < 2; ++n) { const f32x4 xn = b[bj][n] + acc[ai][bj][m][n]; *(f32x4*)(rowp + bj * HALF + n * 16) = xn;
                        if (xg) { q += (xn.x * xn.x + xn.y * xn.y) + (xn.z * xn.z + xn.w * xn.w); const f32x4 y = xn * g4[bj][n];
                            u32x2 w; w.x = cvt_pk_bf16(y.x, y.y); w.y = cvt_pk_bf16(y.z, y.w); *(u32x2*)(xg + (size_t)row * ldc + col0 + bj * HALF + n * 16) = w; } }
                if (xg) { q += __int_as_float(__builtin_amdgcn_ds_bpermute((lane ^ 16) << 2, __float_as_int(q))); q += __int_as_float(__builtin_amdgcn_ds_bpermute((lane ^ 32) << 2, __float_as_int(q)));
                    if (fq == 0) (void)__hip_atomic_fetch_add(ss + row, (u64)(q * SS_SCALE + 0.5f), __ATOMIC_RELAXED, __HIP_MEMORY_SCOPE_AGENT); }
                if (m & 1) asm volatile("" ::: "memory"); }
    }
};
struct EpiF32 {
    static constexpr bool PERM = false, AFTER_DRAIN = false;
    float* out; int ldc; const u64* ss;
    __device__ __forceinline__ void operator()(const f32x4 (&acc)[2][2][4][2], const Unit& u, int wr, int wc, int fr, int fq) const {
        const int col0 = u.pn * BM + wc * 32 + 4 * fq;
#pragma unroll
        for (int ai = 0; ai < 2; ++ai)
#pragma unroll
            for (int m = 0; m < 4; ++m) { const int row = u.pm * BM + ai * HALF + wr * 64 + m * 16 + fr; float* rowp = out + (size_t)row * ldc + col0; const float rs = row_rstd(ss, row);
#pragma unroll
                for (int bj = 0; bj < 2; ++bj)
#pragma unroll
                    for (int n = 0; n < 2; ++n) *(f32x4*)(rowp + bj * HALF + n * 16) = acc[ai][bj][m][n] * rs; }
    }
};

template <class Epi, class Sched, bool ALIGN_EPI = true>
__device__ __forceinline__ void gemm_phase(LAS unsigned char* lds, const Gemm g, const Sched& S, const Epi& E, int wave0) {
    const int lane = fresh_lane(), wid = wave0, tid = wid * 64 + lane;
    const int wr = wid >> 2, wc = wid & 3, fr = lane & 15, fq = lane >> 4;
    const int K = g.K, nt = K / BK;
    unsigned voffA[2], voffB[2];
#pragma unroll
    for (int i = 0; i < 2; ++i) { int R, C; stage_rc(tid * 16 + i * 8192, R, C); const int Rb = Epi::PERM ? ((R & ~31) + perm32(R & 31)) : R;
        voffA[i] = (unsigned)(R * K + C) * 2u; voffB[i] = (unsigned)(Rb * K + C) * 2u; }
    const size_t kstep = (size_t)(BK * 2);
    const size_t hstep = (size_t)HALF * K * 2;
    const size_t tstep = 2 * hstep;
    const unsigned ldsw = (unsigned)wid * 1024u;
    const int aoff = lds_byte(wr * 64 + fr, fq * 8), boff = lds_byte(wc * 32 + fr, fq * 8);
#define PG8_SA(b, h) (((b) * 2 + (h)) * HTB)
#define PG8_SB(b, h) ((4 + (b) * 2 + (h)) * HTB)
#define PG8_STAGE(bufoff, gbase, voff) do { _Pragma("unroll") for (int _i = 0; _i < 2; ++_i) \
        __builtin_amdgcn_global_load_lds((const unsigned*)((const char*)(gbase) + (voff)[_i]), (LAS unsigned*)(lds + (bufoff) + ldsw + _i * 8192), 16, 0, 0); } while (0)
#define PG8_LDA(dst, b, h) do { _Pragma("unroll") for (int m = 0; m < 4; ++m) _Pragma("unroll") for (int k = 0; k < 2; ++k) dst[m][k] = *(const LAS bf16x8*)(lds + PG8_SA(b, h) + aoff + m * 2048 + k * 1024); } while (0)
#define PG8_LDB(dst, b, h) do { _Pragma("unroll") for (int n = 0; n < 2; ++n) _Pragma("unroll") for (int k = 0; k < 2; ++k) dst[n][k] = *(const LAS bf16x8*)(lds + PG8_SB(b, h) + boff + n * 2048 + k * 1024); } while (0)
#define PG8_MMA(ai, bj, At, Bt) do { __builtin_amdgcn_s_setprio(1); _Pragma("unroll") for (int m = 0; m < 4; ++m) _Pragma("unroll") for (int n = 0; n < 2; ++n) _Pragma("unroll") for (int k = 0; k < 2; ++k) \
        acc[ai][bj][m][n] = __builtin_amdgcn_mfma_f32_16x16x32_bf16(Bt[n][k], At[m][k], acc[ai][bj][m][n], 0, 0, 0); __builtin_amdgcn_s_setprio(0); } while (0)
#define PG8_WAIT_V(n) asm volatile("s_waitcnt vmcnt(" #n ")" ::: "memory")
#define PG8_WAIT_L(n) asm volatile("s_waitcnt lgkmcnt(" #n ")" ::: "memory")
#define PG8_BAR __builtin_amdgcn_s_barrier()
#define PG8_SCHED __builtin_amdgcn_sched_barrier(0)
    Unit cur, nxt; int ui = 0;
    if (!S.next(0, cur)) return;
    f32x4 acc[2][2][4][2];
#pragma unroll
    for (int a = 0; a < 2; ++a)
#pragma unroll
        for (int b = 0; b < 2; ++b)
#pragma unroll
            for (int m = 0; m < 4; ++m)
#pragma unroll
                for (int n = 0; n < 2; ++n) acc[a][b][m][n] = (f32x4){0.f, 0.f, 0.f, 0.f};
    bf16x8 At[4][2], B0[2][2], B1[2][2];
    const char* cA = (const char*)g.A + (size_t)cur.pm * tstep; const char* cB = (const char*)g.Bt + (size_t)cur.pn * tstep;
    S.a_ready(cur);
    PG8_STAGE(PG8_SB(0, 0), cB, voffB); PG8_STAGE(PG8_SB(0, 1), cB + hstep, voffB); PG8_STAGE(PG8_SA(0, 0), cA, voffA); PG8_STAGE(PG8_SA(0, 1), cA + hstep, voffA);
    if (wr == 1) PG8_BAR;
    PG8_WAIT_V(2); PG8_BAR;
    PG8_STAGE(PG8_SB(1, 0), cB + kstep, voffB); PG8_STAGE(PG8_SA(1, 0), cA + kstep, voffA); PG8_STAGE(PG8_SB(1, 1), cB + hstep + kstep, voffB);
    PG8_WAIT_V(6); PG8_BAR;
    for (;;) {
        const bool has_next = S.next(ui + 1, nxt);
        const char* nA = has_next ? (const char*)g.A + (size_t)nxt.pm * tstep : cA; const char* nB = has_next ? (const char*)g.Bt + (size_t)nxt.pn * tstep : cB;
        for (int t = 0; t < nt; t += 2) {
            const bool last = (t == nt - 2);
            const char* a1 = cA + (size_t)(t + 1) * kstep;
            const char* a2 = last ? nA : cA + (size_t)(t + 2) * kstep; const char* b2 = last ? nB : cB + (size_t)(t + 2) * kstep;
            const char* a3 = a2 + kstep; const char* b3 = b2 + kstep;
            if (last && has_next) S.a_ready(nxt);
            PG8_LDB(B0, 0, 0); PG8_LDB(B1, 0, 1); PG8_SCHED; PG8_LDA(At, 0, 0); PG8_STAGE(PG8_SA(1, 1), a1 + hstep, voffA);
            PG8_WAIT_V(8); PG8_WAIT_L(0); PG8_BAR; PG8_MMA(0, 0, At, B0); PG8_MMA(0, 1, At, B1); PG8_BAR; PG8_SCHED;
            PG8_LDA(At, 0, 1); PG8_STAGE(PG8_SB(0, 0), b2, voffB); PG8_STAGE(PG8_SB(0, 1), b2 + hstep, voffB); PG8_STAGE(PG8_SA(0, 0), a2, voffA);
            PG8_WAIT_V(8); PG8_WAIT_L(0); PG8_BAR; PG8_MMA(1, 0, At, B0); PG8_MMA(1, 1, At, B1); PG8_BAR; PG8_SCHED;
            PG8_LDB(B0, 1, 0); PG8_LDB(B1, 1, 1); PG8_SCHED; PG8_LDA(At, 1, 0); PG8_STAGE(PG8_SA(0, 1), a2 + hstep, voffA);
            PG8_WAIT_V(8); PG8_WAIT_L(0); PG8_BAR; PG8_MMA(0, 0, At, B0); PG8_MMA(0, 1, At, B1); PG8_BAR; PG8_SCHED;
            PG8_LDA(At, 1, 1); PG8_STAGE(PG8_SB(1, 0), b3, voffB); PG8_STAGE(PG8_SB(1, 1), b3 + hstep, voffB); PG8_STAGE(PG8_SA(1, 0), a3, voffA);
            PG8_WAIT_V(8); PG8_WAIT_L(0); PG8_BAR; PG8_MMA(1, 0, At, B0); PG8_MMA(1, 1, At, B1); PG8_BAR; PG8_SCHED;
        }
        if constexpr (ALIGN_EPI) { if (wr == 0) PG8_BAR; }
        E(acc, cur, wr, wc, fr, fq); S.done(cur);
        if (!has_next) break;
#pragma unroll
        for (int a = 0; a < 2; ++a)
#pragma unroll
            for (int b = 0; b < 2; ++b)
#pragma unroll
                for (int m = 0; m < 4; ++m)
#pragma unroll
                    for (int n = 0; n < 2; ++n) acc[a][b][m][n] = (f32x4){0.f, 0.f, 0.f, 0.f};
        cur = nxt; cA = nA; cB = nB; ++ui;
        if constexpr (ALIGN_EPI) { if (wr == 1) PG8_BAR; }
    }
    PG8_WAIT_V(0);
    if constexpr (!ALIGN_EPI) { if (wr == 0) PG8_BAR; }
    PG8_BAR;
#undef PG8_SA
#undef PG8_SB
#undef PG8_STAGE
#undef PG8_LDA
#undef PG8_LDB
#undef PG8_MMA
#undef PG8_WAIT_V
#undef PG8_WAIT_L
#undef PG8_BAR
#undef PG8_SCHED
}
}

#define SBAR() __builtin_amdgcn_sched_barrier(0)
__device__ __forceinline__ int crow(int r, int hi) { return (r & 3) + 8 * (r >> 2) + 4 * hi; }
__device__ __forceinline__ int v_st(int k, int c) { const int kk = (k & ~0xC) | ((k & 4) << 1) | ((k & 8) >> 1); return ((kk >> 3) * 4 + (c >> 5)) * 512 + ((kk & 7) * 32 + (c & 31)) * 2; }
__device__ __forceinline__ int v_rd_base(int lane) { return ((lane & 3) << 3) | (((lane >> 2) & 3) << 6) | (((lane >> 4) & 1) << 5) | (((lane >> 5) & 1) << 8); }
constexpr int v_rd_off(int d0, int ks, int half) { return d0 * 512 + ks * 4096 + half * 2048; }
template <int OFF> __device__ __forceinline__ s16x4 tr_read(int vb) {
  s16x4 r; asm volatile("ds_read_b64_tr_b16 %0, %1 offset:%2" : "=&v"(r) : "v"(vb), "i"(OFF) : "memory"); return r;
}
template <int D0> __device__ __forceinline__ void pv_one(f32x16& od, int vb, bf16x8 pa0, bf16x8 pa1, bf16x8 pa2, bf16x8 pa3) {
  const s16x4 l0 = tr_read<v_rd_off(D0, 0, 0)>(vb), h0 = tr_read<v_rd_off(D0, 0, 1)>(vb), l1 = tr_read<v_rd_off(D0, 1, 0)>(vb), h1 = tr_read<v_rd_off(D0, 1, 1)>(vb);
  const s16x4 l2 = tr_read<v_rd_off(D0, 2, 0)>(vb), h2 = tr_read<v_rd_off(D0, 2, 1)>(vb), l3 = tr_read<v_rd_off(D0, 3, 0)>(vb), h3 = tr_read<v_rd_off(D0, 3, 1)>(vb);
  asm volatile("s_waitcnt lgkmcnt(0)" ::: "memory"); SBAR();
#define PK(L, H) (bf16x8){L[0], L[1], L[2], L[3], H[0], H[1], H[2], H[3]}
  od = __builtin_amdgcn_mfma_f32_32x32x16_bf16(pa0, PK(l0, h0), od, 0, 0, 0);
  od = __builtin_amdgcn_mfma_f32_32x32x16_bf16(pa1, PK(l1, h1), od, 0, 0, 0);
  od = __builtin_amdgcn_mfma_f32_32x32x16_bf16(pa2, PK(l2, h2), od, 0, 0, 0);
  od = __builtin_amdgcn_mfma_f32_32x32x16_bf16(pa3, PK(l3, h3), od, 0, 0, 0);
#undef PK
}
__device__ __forceinline__ void pv_d0(f32x16* o, int vb, bf16x8 pa0, bf16x8 pa1, bf16x8 pa2, bf16x8 pa3) {
  pv_one<0>(o[0], vb, pa0, pa1, pa2, pa3); pv_one<1>(o[1], vb, pa0, pa1, pa2, pa3); pv_one<2>(o[2], vb, pa0, pa1, pa2, pa3); pv_one<3>(o[3], vb, pa0, pa1, pa2, pa3);
}
#define PK4(P, BASE, OUT) do { unsigned a0 = cvt_pk_bf16(P[BASE + 0], P[BASE + 1]), a1 = cvt_pk_bf16(P[BASE + 2], P[BASE + 3]);   \
    unsigned b0 = cvt_pk_bf16(P[BASE + 4], P[BASE + 5]), b1 = cvt_pk_bf16(P[BASE + 6], P[BASE + 7]);                              \
    auto r0 = __builtin_amdgcn_permlane32_swap(a0, b0, false, false); auto r1 = __builtin_amdgcn_permlane32_swap(a1, b1, false, false); \
    u32x4 w = {r0[0], r1[0], r0[1], r1[1]}; OUT = *reinterpret_cast<bf16x8*>(&w); } while (0)
__device__ __forceinline__ float half_swap_max(float v) { auto rr = __builtin_amdgcn_permlane32_swap(__float_as_uint(v), __float_as_uint(v), false, false); return fmaxf(__uint_as_float(rr[0]), __uint_as_float(rr[1])); }
__device__ __forceinline__ float half_swap_add(float v) { auto rr = __builtin_amdgcn_permlane32_swap(__float_as_uint(v), __float_as_uint(v), false, false); return __uint_as_float(rr[0]) + __uint_as_float(rr[1]); }

namespace dwa {
constexpr int SLOT = 32768;
constexpr int OFF_WS = 2 * SLOT, LDS_BYTES = OFF_WS + 8 * 256;
constexpr float C_QK = 0.08838834764831845f * LOG2E;
#define KSWZ128(row, colB) ((row) * 256 + ((colB) ^ (((row) & 7) << 4)))
__device__ __forceinline__ void item(const bf16_t* __restrict__ qkvs, bf16_t* __restrict__ og, float* __restrict__ lse, int seqbase, int S, int g, int dil, int res, int n0, int h, char* lds, int wave0) {
  const int lane = fresh_lane(), wid = wave0, tid = wid * 64 + lane, r32 = lane & 31, hi = lane >> 5;
  const int b = wid >> 1, qh = wid & 1;
  const int nblk = (S / dil) >> 6;
  const bf16_t* Qs = qkvs + ((size_t)((g * 3 + 0) * NH + h) * CHUNK + seqbase) * 128;
  const bf16_t* Ks = qkvs + ((size_t)((g * 3 + 1) * NH + h) * CHUNK + seqbase) * 128;
  const bf16_t* Vs = qkvs + ((size_t)((g * 3 + 2) * NH + h) * CHUNK + seqbase) * 128;
  const int a = 32 * qh + r32;
  const long qtok = (long)(64 * (n0 + b) + a) * dil + res;
  bf16x8 qr[8];
#pragma unroll
  for (int d0 = 0; d0 < 8; ++d0) qr[d0] = *(const bf16x8*)(Qs + qtok * 128 + d0 * 16 + hi * 8);
  float* al_l = (float*)(lds + OFF_WS + wid * 256);
  const int sr = tid >> 4, sc = (tid & 15) * 8, vst0 = v_st(sr, sc), vst1 = v_st(32 + sr, sc);
  const int vrd = v_rd_base(lane);
  float m_reg = -1e30f, l_reg = 0.f; f32x16 o[4] = {};
  const float slope2 = __builtin_amdgcn_exp2f(-0.5f * (float)(h + 1)) * (float)dil * LOG2E;
  const int t_lo = (n0 == 0) ? 1 : 0, t_hi = (n0 + 4 >= nblk) ? 4 : 5;
  bf16x8 ks0, ks1, vs0, vs1;
#define DW_SLOAD(t) do { const long k0_ = (long)(64 * (n0 - 1 + (t)) + sr) * dil + res, k1_ = k0_ + (long)32 * dil; \
    ks0 = *(const bf16x8*)(Ks + k0_ * 128 + sc); ks1 = *(const bf16x8*)(Ks + k1_ * 128 + sc); vs0 = *(const bf16x8*)(Vs + k0_ * 128 + sc); vs1 = *(const bf16x8*)(Vs + k1_ * 128 + sc); } while (0)
#define DW_SWRITE(slot) do { char* s_ = lds + (slot) * SLOT; *(bf16x8*)(s_ + KSWZ128(sr, sc * 2)) = ks0; *(bf16x8*)(s_ + KSWZ128(32 + sr, sc * 2)) = ks1; \
    *(bf16x8*)(s_ + 16384 + vst0) = vs0; *(bf16x8*)(s_ + 16384 + vst1) = vs1; } while (0)
  DW_SLOAD(t_lo); asm volatile("s_waitcnt vmcnt(0)" ::: "memory"); DW_SWRITE(t_lo & 1); __syncthreads();
  for (int t = t_lo; t <= t_hi; ++t) {
    if (t < t_hi) DW_SLOAD(t + 1);
    if (b <= t && t <= b + 2) {
      const int kt = t - b - 1; const char* Kt = lds + (t & 1) * SLOT;
      f32x16 p0 = {}, p1 = {};
#pragma unroll
      for (int d0 = 0; d0 < 8; ++d0) { const int cb = (d0 * 16 + hi * 8) * 2;
        const bf16x8 b0 = *reinterpret_cast<const bf16x8*>(Kt + KSWZ128(r32, cb)), b1 = *reinterpret_cast<const bf16x8*>(Kt + KSWZ128(32 + r32, cb));
        p0 = __builtin_amdgcn_mfma_f32_32x32x16_bf16(b0, qr[d0], p0, 0, 0, 0); p1 = __builtin_amdgcn_mfma_f32_32x32x16_bf16(b1, qr[d0], p1, 0, 0, 0); }
      float pmax = -1e30f;
#pragma unroll
      for (int rr = 0; rr < 16; ++rr) { const int rel0 = a - crow(rr, hi) - 64 * kt, rel1 = rel0 - 32; const int ar0 = rel0 < 0 ? -rel0 : rel0, ar1 = rel1 < 0 ? -rel1 : rel1;
        p0[rr] = ar0 <= 64 ? fmaf(p0[rr], C_QK, -slope2 * (float)ar0) : -1e30f; p1[rr] = ar1 <= 64 ? fmaf(p1[rr], C_QK, -slope2 * (float)ar1) : -1e30f;
        pmax = fmaxf(pmax, fmaxf(p0[rr], p1[rr])); }
      pmax = half_swap_max(pmax);
      const float mn = fmaxf(m_reg, pmax), alpha = __builtin_amdgcn_exp2f(m_reg - mn); m_reg = mn;
      float ps = 0.f;
#pragma unroll
      for (int rr = 0; rr < 16; ++rr) { p0[rr] = __builtin_amdgcn_exp2f(p0[rr] - mn); p1[rr] = __builtin_amdgcn_exp2f(p1[rr] - mn); ps += p0[rr] + p1[rr]; }
      ps = half_swap_add(ps); l_reg = l_reg * alpha + ps;
      bf16x8 pa0, pa1, pa2, pa3; PK4(p0, 0, pa0); PK4(p0, 8, pa1); PK4(p1, 0, pa2); PK4(p1, 8, pa3);
      if (hi == 0) al_l[r32] = alpha; asm volatile("s_waitcnt lgkmcnt(0)" ::: "memory");
#pragma unroll
      for (int rr = 0; rr < 16; ++rr) { const float al = al_l[crow(rr, hi)];
#pragma unroll
        for (int d = 0; d < 4; ++d) o[d][rr] *= al; }
      asm volatile("s_waitcnt lgkmcnt(0)" ::: "memory");
      SBAR();
      pv_d0(o, (int)(uintptr_t)(lds + (t & 1) * SLOT + 16384) + vrd, pa0, pa1, pa2, pa3);
    }
    if (t < t_hi) { asm volatile("s_waitcnt vmcnt(0)" ::: "memory"); DW_SWRITE((t + 1) & 1); }
    __syncthreads();
  }
#undef DW_SLOAD
#undef DW_SWRITE
  if (hi == 0) al_l[r32] = __builtin_amdgcn_rcpf(l_reg); asm volatile("s_waitcnt lgkmcnt(0)" ::: "memory");
  bf16_t* stg = (bf16_t*)(lds + wid * 8192);
#pragma unroll
  for (int rr = 0; rr < 16; ++rr) { const int row = crow(rr, hi); const float li = al_l[row];
#pragma unroll
    for (int d = 0; d < 4; ++d) { const unsigned w = cvt_pk_bf16(o[d][rr] * li, 0.f); stg[row * 128 + d * 32 + r32] = (bf16_t)(w & 0xffffu); } }
  asm volatile("s_waitcnt lgkmcnt(0)" ::: "memory");
  const int er = lane >> 4, ec = (lane & 15) * 8;
#pragma unroll
  for (int i = 0; i < 8; ++i) { const int row = er + 4 * i; const long tok = seqbase + (long)(64 * (n0 + b) + 32 * qh + row) * dil + res;
    *(u32x4*)(og + (tok * 3 + g) * DM + h * 128 + ec) = *(const u32x4*)(stg + row * 128 + ec); }
  if (hi == 0) lse[((seqbase + qtok) * 3 + g) * NH + h] = m_reg + __builtin_amdgcn_logf(l_reg);
  asm volatile("s_waitcnt lgkmcnt(0)" ::: "memory");
  __syncthreads();
}
}

namespace mla {
constexpr int NW = 8, QBLK = 32, KVBLK = 64;
constexpr float SCALE = 0.07216878364870322f;
constexpr float THR = 8.f;
constexpr int LDQ = NQ, LDKV = NKV, LDKR = 64, LDO = DM;
constexpr int SHM_V = KVBLK * 128 * 2, SHM_K = KVBLK * 192 * 2;
constexpr int OFF_V = 0, OFF_K = 2 * SHM_V, OFF_WS = 2 * SHM_V + 2 * SHM_K, OFF_QR = OFF_WS + NW * 64 * 4, LDS_BYTES = OFF_QR + NW * 4096;
#define KSWZ192(row, colB) ((row) * 384 + ((colB) ^ (((row) & 7) << 4)))

__device__ __forceinline__ void partialSM(f32x16& p0, f32x16& p1, float& m_reg, float& mn, float& alpha) {
  constexpr float C = SCALE * LOG2E;
  float pmax = p0[0];
#pragma unroll
  for (int r = 1; r < 16; ++r) pmax = fmaxf(pmax, p0[r]);
#pragma unroll
  for (int r = 0; r < 16; ++r) pmax = fmaxf(pmax, p1[r]);
  pmax = half_swap_max(pmax);
  if (__builtin_expect(__all(pmax - m_reg <= THR / SCALE), 1)) { mn = m_reg; alpha = 1.f; }
  else { mn = fmaxf(m_reg, pmax); alpha = __builtin_amdgcn_exp2f((m_reg - mn) * C); m_reg = mn; }
  const float mnC = -mn * C;
#pragma unroll
  for (int r = 0; r < 16; ++r) p0[r] = fmaf(p0[r], C, mnC);
#pragma unroll
  for (int r = 0; r < 16; ++r) p1[r] = fmaf(p1[r], C, mnC);
#pragma unroll
  for (int r = 0; r < 16; ++r) p0[r] = __builtin_amdgcn_exp2f(p0[r]);
}
__device__ __forceinline__ void finishSM(f32x16& p0, f32x16& p1, float alpha, float& l_reg, bf16x8& pa0, bf16x8& pa1, bf16x8& pa2, bf16x8& pa3) {
#pragma unroll
  for (int r = 0; r < 16; ++r) p1[r] = __builtin_amdgcn_exp2f(p1[r]);
  float ps = 0;
#pragma unroll
  for (int r = 0; r < 16; ++r) ps += p0[r];
#pragma unroll
  for (int r = 0; r < 16; ++r) ps += p1[r];
  ps = half_swap_add(ps);
  l_reg = l_reg * alpha + ps;
  PK4(p0, 0, pa0); PK4(p0, 8, pa1); PK4(p1, 0, pa2); PK4(p1, 8, pa3);
}
__device__ __forceinline__ void qkt(f32x16& p0, f32x16& p1, const char* Ks, const bf16x8* qr, const char* qrl, int r32, int hi) {
  p0 = f32x16{}; p1 = f32x16{};
#pragma unroll
  for (int d0 = 0; d0 < 12; ++d0) { const int cb = (d0 * 16 + hi * 8) * 2;
    const bf16x8 b0 = *reinterpret_cast<const bf16x8*>(Ks + KSWZ192(r32, cb));
    const bf16x8 b1 = *reinterpret_cast<const bf16x8*>(Ks + KSWZ192(32 + r32, cb));
    const bf16x8 qf = d0 < 8 ? qr[d0 < 8 ? d0 : 0] : *reinterpret_cast<const bf16x8*>(qrl + (d0 - 8) * 1024);
    p0 = __builtin_amdgcn_mfma_f32_32x32x16_bf16(b0, qf, p0, 0, 0, 0);
    p1 = __builtin_amdgcn_mfma_f32_32x32x16_bf16(b1, qf, p1, 0, 0, 0); }
}
__device__ __forceinline__ void attn_unit(const bf16_t* __restrict__ Qb, const bf16_t* __restrict__ Kn, const bf16_t* __restrict__ Kr, const bf16_t* __restrict__ Vh, bf16_t* __restrict__ Ob, int seq, char* lds, int wave0) {
  const int lane = fresh_lane(), wid = wave0, tid = wid * 64 + lane, r32 = lane & 31, hi = lane >> 5;
  char* V_lds = lds + OFF_V; char* K_lds = lds + OFF_K;
  float* ws = (float*)(lds + OFF_WS) + wid * 64; float* li_l = ws; float* al_l = ws + 32;
  float m_reg = -1e30f, l_reg = 0; f32x16 o[4] = {}; bf16x8 qr[8];
  const bf16_t* Qw = Qb + (long)(wid * QBLK + r32) * LDQ + hi * 8;
#pragma unroll
  for (int d0 = 0; d0 < 8; ++d0) qr[d0] = *reinterpret_cast<const bf16x8*>(Qw + d0 * 16);
  char* const qrl = lds + OFF_QR + wid * 4096 + lane * 16;
#pragma unroll
  for (int d0 = 0; d0 < 4; ++d0) *reinterpret_cast<bf16x8*>(qrl + d0 * 1024) = *reinterpret_cast<const bf16x8*>(Qw + (8 + d0) * 16);
  const int sr = tid >> 4, sc = (tid & 15) * 8, vst0 = v_st(sr, sc), vst1 = v_st(32 + sr, sc);
  const int rr_ = tid >> 3, rc = (tid & 7) * 8;
  const int vb0 = (int)(uintptr_t)V_lds + v_rd_base(lane);
  struct { bf16x8 vs0, vs1, ks0, ks1, kr; } sr_[1];
#define SLOAD(i, k0) do { sr_[i].vs0 = *reinterpret_cast<const bf16x8*>(&Vh[(long)((k0) + sr) * LDKV + sc]); sr_[i].vs1 = *reinterpret_cast<const bf16x8*>(&Vh[(long)((k0) + 32 + sr) * LDKV + sc]); \
    sr_[i].ks0 = *reinterpret_cast<const bf16x8*>(&Kn[(long)((k0) + sr) * LDKV + sc]); sr_[i].ks1 = *reinterpret_cast<const bf16x8*>(&Kn[(long)((k0) + 32 + sr) * LDKV + sc]); \
    sr_[i].kr = *reinterpret_cast<const bf16x8*>(&Kr[(long)((k0) + rr_) * LDKR + rc]); } while (0)
#define SWRITE(b, i) do { *(bf16x8*)(V_lds + (b) * SHM_V + vst0) = sr_[i].vs0; *(bf16x8*)(V_lds + (b) * SHM_V + vst1) = sr_[i].vs1; const int kc = sc * 2; \
    *(bf16x8*)(K_lds + (b) * SHM_K + KSWZ192(sr, kc)) = sr_[i].ks0; *(bf16x8*)(K_lds + (b) * SHM_K + KSWZ192(32 + sr, kc)) = sr_[i].ks1; \
    *(bf16x8*)(K_lds + (b) * SHM_K + KSWZ192(rr_, 256 + rc * 2)) = sr_[i].kr; } while (0)
#define SWAIT() asm volatile("s_waitcnt vmcnt(0)" ::: "memory")
#define RESC(a) do { if (__any((a) < 1.f)) { if (hi == 0) al_l[r32] = (a); asm volatile("s_waitcnt lgkmcnt(0)" ::: "memory"); \
    _Pragma("unroll") for (int d = 0; d < 4; ++d) _Pragma("unroll") for (int r = 0; r < 16; ++r) o[d][r] *= al_l[crow(r, hi)]; } } while (0)
  f32x16 pA0, pA1, pB0, pB1; float mnA, mnB, alA, alB; bf16x8 pa0, pa1, pa2, pa3; const int NT = seq / KVBLK;
  constexpr int SE = 0, SO = 0;
  SLOAD(SE, 0); asm volatile("s_waitcnt vmcnt(0)" ::: "memory"); SWRITE(0, SE); __syncthreads();
  qkt(pA0, pA1, K_lds, qr, qrl, r32, hi); partialSM(pA0, pA1, m_reg, mnA, alA);
  SLOAD(SO, KVBLK);
  SWAIT(); SWRITE(1, SO); __syncthreads();
  for (int j = 1; j + 1 < NT; j += 2) {
    SBAR(); qkt(pB0, pB1, K_lds + SHM_K, qr, qrl, r32, hi);
    finishSM(pA0, pA1, alA, l_reg, pa0, pa1, pa2, pa3); SBAR();
    SLOAD(SE, (j + 1) * KVBLK); SBAR();
    pv_d0(o, vb0, pa0, pa1, pa2, pa3); partialSM(pB0, pB1, m_reg, mnB, alB);
    __syncthreads(); SWAIT(); SWRITE(0, SE);
    RESC(alB); __syncthreads();
    SBAR(); qkt(pA0, pA1, K_lds, qr, qrl, r32, hi);
    finishSM(pB0, pB1, alB, l_reg, pa0, pa1, pa2, pa3); SBAR();
    SLOAD(SO, (j + 2) * KVBLK); SBAR();
    pv_d0(o, vb0 + SHM_V, pa0, pa1, pa2, pa3); partialSM(pA0, pA1, m_reg, mnA, alA);
    __syncthreads(); SWAIT(); SWRITE(1, SO);
    RESC(alA); __syncthreads();
  }
  SBAR(); qkt(pB0, pB1, K_lds + SHM_K, qr, qrl, r32, hi);
  finishSM(pA0, pA1, alA, l_reg, pa0, pa1, pa2, pa3); SBAR();
  pv_d0(o, vb0, pa0, pa1, pa2, pa3); partialSM(pB0, pB1, m_reg, mnB, alB);
  __syncthreads(); RESC(alB);
  finishSM(pB0, pB1, alB, l_reg, pa0, pa1, pa2, pa3); SBAR();
  pv_d0(o, vb0 + SHM_V, pa0, pa1, pa2, pa3);
  if (hi == 0) li_l[r32] = l_reg; asm volatile("s_waitcnt lgkmcnt(0)" ::: "memory");
  __syncthreads();
  bf16_t* stg = (bf16_t*)(lds + OFF_V + wid * 8192);
#pragma unroll
  for (int r = 0; r < 16; ++r) { const int row = crow(r, hi); const float li = __builtin_amdgcn_rcpf(li_l[row]);
#pragma unroll
    for (int d = 0; d < 4; ++d) { const unsigned w = cvt_pk_bf16(o[d][r] * li, 0.f); stg[row * 128 + d * 32 + r32] = (bf16_t)(w & 0xffffu); } }
  asm volatile("s_waitcnt lgkmcnt(0)" ::: "memory");
  const int er = lane >> 4, ec = (lane & 15) * 8;
#pragma unroll
  for (int i = 0; i < 8; ++i) { const int row = er + 4 * i;
    *(u32x4*)(Ob + (long)(wid * QBLK + row) * LDO + ec) = *(const u32x4*)(stg + row * 128 + ec); }
  asm volatile("s_waitcnt lgkmcnt(0)" ::: "memory");
  __syncthreads();
#undef SLOAD
#undef SWRITE
#undef SWAIT
#undef RESC
}
}

constexpr int NWAVES = 8;
constexpr int NBLK = 256;
constexpr size_t MiB = 1u << 20;
constexpr size_t WS_CTL = 0, WS_SS = 1 * MiB, CTL_ZERO_BYTES = 4 * MiB;
constexpr size_t WS_ROPE_C = 150 * MiB, WS_ROPE_S = 151 * MiB;
constexpr size_t WS_W = 4 * MiB;
constexpr size_t W_QKV = WS_W, W_WA = WS_W, W_UQ = WS_W + 4 * MiB, W_UKV = WS_W + 8 * MiB;
constexpr size_t W_O = WS_W + 72 * MiB, W_GU = WS_W + 80 * MiB, W_DN = WS_W + 124 * MiB;
constexpr size_t WS_H = 152 * MiB;
constexpr size_t WS_S = 312 * MiB;
constexpr size_t S_QKV = WS_S, S_OG = WS_S + 288 * MiB, S_LSE = WS_S + 384 * MiB, S_OA = WS_S + 386 * MiB;
constexpr size_t S_ACT = WS_S;
constexpr size_t S_KV = WS_S, S_A = WS_S, S_CQ = WS_S + 320 * MiB, S_CKV = WS_S + 360 * MiB, S_KR = WS_S + 400 * MiB, S_Q = WS_S + 405 * MiB, S_OB = WS_S + 645 * MiB;
constexpr size_t WS_END = WS_S + 805 * MiB;
static_assert(S_OA + (size_t)T_ALL * DM * 2 <= WS_END && S_Q + (size_t)T_ALL * NQ * 2 <= S_OB && S_OB + (size_t)T_ALL * DM * 2 <= WS_END && S_ACT + (size_t)T_ALL * DFF * 2 <= WS_END, "d_ws map");
static_assert(W_DN + (size_t)DM * DFF * 2 <= WS_H && W_QKV + (size_t)NQKV * DM * 2 <= W_O && WS_H + (size_t)T_ALL * DM * 2 <= WS_S && WS_SS + (size_t)9 * T_ALL * 8 <= CTL_ZERO_BYTES && W_DN + (size_t)DM * DFF * 2 <= WS_ROPE_C, "d_ws map");
constexpr int CW_TMO = 0, CW_CODE = 1, CW_BAR = 4096;

constexpr int RING_OFF = 0, RING_BYTES = 146432;
constexpr int LDSCTL_OFF = RING_BYTES, MISC_OFF = LDSCTL_OFF + 320;
constexpr int LDS_BYTES = 147456;
static_assert(MISC_OFF + 128 <= LDS_BYTES && dwa::LDS_BYTES <= RING_BYTES && mla::LDS_BYTES <= RING_BYTES && pg8::STAGE_BYTES <= RING_BYTES, "LDS map");

#define RLX_AGENT __ATOMIC_RELAXED, __HIP_MEMORY_SCOPE_AGENT
#define LDS_WAIT() asm volatile("s_waitcnt lgkmcnt(0)" ::: "memory")
#define VM_WAIT() asm volatile("s_waitcnt vmcnt(0)" ::: "memory")
__device__ __forceinline__ unsigned f2bf(float f) { unsigned u = __builtin_bit_cast(unsigned, f); return (u + 0x7fffu + ((u >> 16) & 1u)) >> 16; }
__device__ __forceinline__ unsigned pk2(float lo, float hi) { return f2bf(lo) | (f2bf(hi) << 16); }

#define XB_TMO      128
#define XB_XCNT(j)  (256  + 64 * (j))
#define XB_XSUB(j)  (1280 + 64 * (j))
#define XB_XGEN(j)  (2304 + 64 * (j))
#define XB_TOP      3328
#define XB_TOPGEN   3392
#define XCD_BAR_WORDS 3456
#define XB_SPIN_CAP (1u << 18)
__device__ __forceinline__ unsigned xb_ld(unsigned* p)              { return __hip_atomic_load(p, __ATOMIC_RELAXED, __HIP_MEMORY_SCOPE_AGENT); }
__device__ __forceinline__ unsigned xb_add(unsigned* p, unsigned v) { return __hip_atomic_fetch_add(p, v, __ATOMIC_RELAXED, __HIP_MEMORY_SCOPE_AGENT); }
__device__ __forceinline__ unsigned xb_xcc_id() { return (unsigned)__builtin_amdgcn_s_getreg((3 << 11) | 20) & 0xFu; }
#define XB_SPIN(cond, bar) do { unsigned _sp = 0; while (cond) { __builtin_amdgcn_s_sleep(1); \
    if ((++_sp & 255u) == 0u) { if (xb_ld(&(bar)[XB_TMO])) break; if (_sp > XB_SPIN_CAP) { atomicAdd(&(bar)[XB_TMO], 1u); break; } } } } while (0)
struct XcdBarrier { unsigned* bar; unsigned x; volatile LAS unsigned* st; bool leader; };
__device__ __forceinline__ XcdBarrier xcd_barrier_post(unsigned* bar, volatile LAS unsigned* st) {
    XcdBarrier b; b.bar = bar; b.x = xb_xcc_id(); b.st = st; b.leader = threadIdx.x == 0;
    if (b.leader) (void)xb_add(&bar[XB_XCNT(b.x)], 1u);
    return b;
}
__device__ __forceinline__ void xcd_barrier_complete(unsigned* bar, unsigned x, unsigned& nloc, unsigned& nx) {
    const unsigned G = gridDim.x * gridDim.y * gridDim.z;
    unsigned sum, cnt, mine, sp = 0u;
    for (;;) {
        sum = 0u; cnt = 0u; mine = 0u;
#pragma unroll
        for (unsigned j = 0; j < 16; ++j) { const unsigned c = xb_ld(&bar[XB_XCNT(j)]); sum += c; cnt += (c > 0u) ? 1u : 0u; mine = (j == x) ? c : mine; }
        if (sum == G) break;
        __builtin_amdgcn_s_sleep(1);
        if ((++sp & 255u) == 0u) { if (xb_ld(&bar[XB_TMO])) break; if (sp > XB_SPIN_CAP) { atomicAdd(&bar[XB_TMO], 1u); break; } }
    }
    nloc = mine > 0u ? mine : 1u; nx = cnt > 0u ? cnt : 1u;
}
__device__ __forceinline__ void xcd_barrier(const XcdBarrier& b) {
    asm volatile("s_waitcnt vmcnt(0)" ::: "memory");
    __syncthreads();
    if (b.leader) {
        unsigned* bar = b.bar;
        __builtin_amdgcn_s_waitcnt(0);
        unsigned nloc = b.st[0], nx = b.st[1];
        if (nloc == 0u) { xcd_barrier_complete(bar, b.x, nloc, nx); b.st[0] = nloc; b.st[1] = nx; }
        const unsigned old = xb_add(&bar[XB_XSUB(b.x)], 1u);
        const unsigned gen = old / nloc;
        if (old + 1u == (gen + 1u) * nloc) {
            __builtin_amdgcn_fence(__ATOMIC_RELEASE, "agent");
            asm volatile("s_waitcnt vmcnt(0)" ::: "memory");
            const unsigned og = xb_add(&bar[XB_TOP], 1u);
            const unsigned tg = og / nx;
            if (og + 1u == (tg + 1u) * nx) xb_add(&bar[XB_TOPGEN], 1u);
            else XB_SPIN(xb_ld(&bar[XB_TOPGEN]) == tg, bar);
            __builtin_amdgcn_fence(__ATOMIC_ACQUIRE, "agent");
            xb_add(&bar[XB_XGEN(b.x)], 1u);
            asm volatile("s_waitcnt vmcnt(0)" ::: "memory");
        } else {
            XB_SPIN(xb_ld(&bar[XB_XGEN(b.x)]) == gen, bar);
            __builtin_amdgcn_fence(__ATOMIC_ACQUIRE, "agent");
            asm volatile("s_waitcnt vmcnt(0)" ::: "memory");
        }
    }
    __syncthreads();
}

__device__ __forceinline__ float shfl_xor_f(float v, int o, int lane) { return __int_as_float(__builtin_amdgcn_ds_bpermute((lane ^ o) << 2, __float_as_int(v))); }
__device__ __forceinline__ float wave_sum(float v, int lane) {
#pragma unroll
    for (int o = 1; o < 64; o <<= 1) v += shfl_xor_f(v, o, lane);
    return v;
}
template <int MODE> __device__ __forceinline__ int wmap(int c) {
    if (MODE == 1) return 256 * (c >> 7) + (c & 127);
    if (MODE == 2) return 256 * (c >> 7) + 128 + (c & 127);
    if (MODE == 3) { const int h = c / 192, w = c % 192; if (w < 128) return c; int j = w - 128;
        if (j < 32) return h * 192 + 128 + 8 * (j >> 2) + (j & 3); j -= 32; return h * 192 + 128 + 8 * (j >> 2) + 4 + (j & 3); }
    return c;
}
template <int MODE> __device__ __forceinline__ void tr_item(const float* __restrict__ W, int N, bf16_t* __restrict__ WT, int Kd, LAS float* scr, int item, int lane) {
    const int nblk = N / 32, kb = item / nblk, nb = item % nblk, k0 = 64 * kb, n0 = 32 * nb;
#pragma unroll 8
    for (int i = 0; i < 32; ++i) { const int kk = 2 * i + (lane >> 5); scr[kk * 33 + (lane & 31)] = W[(size_t)(k0 + kk) * N + n0 + (lane & 31)]; }
    LDS_WAIT(); asm volatile("" ::: "memory");
    const int c = lane & 7;
#pragma unroll
    for (int j = 0; j < 4; ++j) { const int n = (lane >> 3) + 8 * j; const LAS float* s = scr + (8 * c) * 33 + n;
        u32x4 o; o.x = pk2(s[0 * 33], s[1 * 33]); o.y = pk2(s[2 * 33], s[3 * 33]); o.z = pk2(s[4 * 33], s[5 * 33]); o.w = pk2(s[6 * 33], s[7 * 33]);
        *(GAS u32x4*)(WT + (size_t)wmap<MODE>(n0 + n) * Kd + k0 + 8 * c) = o; }
    LDS_WAIT(); asm volatile("" ::: "memory");
}
__device__ __forceinline__ void prep_row0(const float* __restrict__ xrow, const f32x4 (&g)[8], bf16_t* __restrict__ orow, float* __restrict__ copy_row, pg8::u64* __restrict__ ssp, int lane) {
    const GAS f32x4* xr = (const GAS f32x4*)xrow + lane;
    f32x4 v[8]; float s = 0.f;
#pragma unroll
    for (int j = 0; j < 8; ++j) { v[j] = xr[64 * j]; s += (v[j].x * v[j].x + v[j].y * v[j].y) + (v[j].z * v[j].z + v[j].w * v[j].w); }
    s = wave_sum(s, lane);
    if (lane == 0) *ssp = (pg8::u64)(s * pg8::SS_SCALE + 0.5f);
    GAS f32x4* cr = (GAS f32x4*)copy_row + lane;
#pragma unroll
    for (int j = 0; j < 8; ++j) cr[64 * j] = v[j];
    GAS u32x2* o8 = (GAS u32x2*)orow + lane;
#pragma unroll
    for (int j = 0; j < 8; ++j) { const f32x4 y = v[j] * g[j]; u32x2 w; w.x = cvt_pk_bf16(y.x, y.y); w.y = cvt_pk_bf16(y.z, y.w); o8[64 * j] = w; }
}
__device__ __forceinline__ void rms_row_f32(float* __restrict__ xrow, const f32x4 (&g)[8], int lane) {
    GAS f32x4* xr = (GAS f32x4*)xrow + lane;
    f32x4 v[8]; float s = 0.f;
#pragma unroll
    for (int j = 0; j < 8; ++j) { v[j] = xr[64 * j]; s += (v[j].x * v[j].x + v[j].y * v[j].y) + (v[j].z * v[j].z + v[j].w * v[j].w); }
    const float rstd = 1.f / sqrtf(wave_sum(s, lane) * (1.f / DM) + NORM_EPS);
#pragma unroll
    for (int j = 0; j < 8; ++j) xr[64 * j] = (v[j] * rstd) * g[j];
}
__device__ __forceinline__ void sincos_d(double x, double& s, double& c) {
    const double q = __builtin_rint(x * 0.63661977236758134308);
    double y = __builtin_fma(-q, 1.57079632679489655800e+00, x); y = __builtin_fma(-q, 6.12323399573676603587e-17, y);
    const int qi = (int)q; const double y2 = y * y;
    const double sp = y * (1.0 + y2 * (-1.0 / 6.0 + y2 * (1.0 / 120.0 + y2 * (-1.0 / 5040.0 + y2 * (1.0 / 362880.0 + y2 * (-1.0 / 39916800.0 + y2 * (1.0 / 6227020800.0 + y2 * (-1.0 / 1307674368000.0))))))));
    const double cp = 1.0 + y2 * (-0.5 + y2 * (1.0 / 24.0 + y2 * (-1.0 / 720.0 + y2 * (1.0 / 40320.0 + y2 * (-1.0 / 3628800.0 + y2 * (1.0 / 479001600.0 + y2 * (-1.0 / 87178291200.0 + y2 * (1.0 / 20922789888000.0))))))));
    const int k = qi & 3;
    s = (k == 0) ? sp : (k == 1) ? cp : (k == 2) ? -sp : -cp;
    c = (k == 0) ? cp : (k == 1) ? -sp : (k == 2) ? -cp : sp;
}
__device__ __forceinline__ double inv_freq(int j) {
    const int a = j >> 3, b = j & 7;
    const double pa = (a == 0) ? 1.0 : (a == 1) ? 0.1 : (a == 2) ? 0.01 : 0.001;
    const double pb = (b == 0) ? 1.0 : (b == 1) ? 0.7498942093324559 : (b == 2) ? 0.5623413251903491 : (b == 3) ? 0.4216965034285822 : (b == 4) ? 0.31622776601683794
                    : (b == 5) ? 0.23713737056616552 : (b == 6) ? 0.1778279410038923 : 0.1333521432163324;
    return pa * pb;
}

struct Args { const float* in[16]; float* out; unsigned char* ws; };
typedef const __attribute__((address_space(4))) Args* KArgs;
__device__ __forceinline__ KArgs kargs() { auto p = __builtin_amdgcn_kernarg_segment_ptr(); asm volatile("" : "+s"(p)); return (KArgs)p; }
#define KA_IN(i) (kargs()->in[i])
#define KA_WS() (kargs()->ws)
#define KA_OUT() (kargs()->out)
__global__ void __launch_bounds__(NWAVES * 64, 2) fwd(Args args) {
    (void)args;
    extern __shared__ __attribute__((aligned(16))) unsigned char lds[];
    LAS unsigned char* const ldsl = (LAS unsigned char*)lds;
    const int wave0 = __builtin_amdgcn_readfirstlane(threadIdx.x >> 6);
    constexpr int G = NBLK; const int bx = blockIdx.x, vcu = (bx % 8) * (G / 8) + bx / 8;
    constexpr int NGW = G * NWAVES, NGT = G * NWAVES * 64;
#define IDS() int wave_ = wave0; asm volatile("" : "+s"(wave_)); const int lane = fresh_lane(), wave = wave_, tid = wave * 64 + lane; const int gw = vcu * NWAVES + wave, gt = vcu * (NWAVES * 64) + tid; (void)lane; (void)gw; (void)gt; (void)tid
    { IDS(); for (int u = tid; u < (LDS_BYTES - LDSCTL_OFF) / 4; u += NWAVES * 64) ((LAS unsigned*)(ldsl + LDSCTL_OFF))[u] = 0u; }
    __syncthreads();
    XcdBarrier bar0 = xcd_barrier_post((unsigned*)(KA_WS() + WS_CTL) + CW_BAR, (volatile LAS unsigned*)(ldsl + MISC_OFF) + 8);
    const unsigned bar_x = bar0.x;
#define GRID_BAR() do { XcdBarrier b_; b_.bar = (unsigned*)(KA_WS() + WS_CTL) + CW_BAR; b_.x = bar_x; b_.st = (volatile LAS unsigned*)(ldsl + MISC_OFF) + 8; b_.leader = (wave0 == 0) && (fresh_lane() == 0); xcd_barrier(b_); } while (0)
#define SCR() ((LAS float*)(ldsl + RING_OFF + wave * 16384))

    { IDS(); unsigned char* const ws = KA_WS(); float* const tabc = (float*)(ws + WS_ROPE_C); float* const tabs = (float*)(ws + WS_ROPE_S);
      for (int e = gt; e < SEQ_P * 32; e += NGT) { const int pos = e >> 5, j = e & 31; double s, c; sincos_d((double)pos * inv_freq(j), s, c); tabc[e] = (float)c; tabs[e] = (float)s; } }

    for (int layer = 0; layer < 4; ++layer) {
        const int lj = layer >> 1; const bool isB = (layer & 1) != 0;
        for (int rep = 0; rep < REP_THIN; ++rep)
        {
            constexpr int I_G = (DM / 64) * (DFF / 32), I_D = (DFF / 64) * (DM / 32), I_O = (DM / 64) * (DM / 32);
            if (!isB) {
                constexpr int I_QKV = (DM / 64) * (NQKV / 32);
                { IDS(); unsigned char* const ws = KA_WS(); const float* wqkv = KA_IN(5) + (size_t)lj * DM * NQKV;
                  for (int it = gw; it < I_QKV; it += NGW) tr_item<0>(wqkv, NQKV, (bf16_t*)(ws + W_QKV), DM, SCR(), it, lane); }
                { IDS(); unsigned char* const ws = KA_WS(); const float* wo = KA_IN(6) + (size_t)lj * DM * DM;
                  for (int it = gw; it < I_O; it += NGW) tr_item<0>(wo, DM, (bf16_t*)(ws + W_O), DM, SCR(), it, lane); }
            } else {
                constexpr int I_A = (DM / 64) * (NA / 32), I_UQ = (QLR / 64) * (NQ / 32), I_UKV = (KVL / 64) * (NKV / 32);
                { IDS(); unsigned char* const ws = KA_WS(); const float* wa = KA_IN(7) + (size_t)lj * DM * NA;
                  for (int it = gw; it < I_A; it += NGW) tr_item<0>(wa, NA, (bf16_t*)(ws + W_WA), DM, SCR(), it, lane); }
                { IDS(); unsigned char* const ws = KA_WS(); const float* wuq = KA_IN(10) + (size_t)lj * QLR * NQ;
                  for (int it = gw; it < I_UQ; it += NGW) tr_item<3>(wuq, NQ, (bf16_t*)(ws + W_UQ), QLP, SCR(), it, lane);
                  for (int e = gt; e < NQ * 8; e += NGT) *(GAS u32x4*)((bf16_t*)(ws + W_UQ) + (size_t)(e >> 3) * QLP + QLR + (e & 7) * 8) = (u32x4){0u, 0u, 0u, 0u}; }
                { IDS(); unsigned char* const ws = KA_WS(); const float* wukv = KA_IN(11) + (size_t)lj * KVL * NKV;
                  for (int it = gw; it < I_UKV; it += NGW) tr_item<0>(wukv, NKV, (bf16_t*)(ws + W_UKV), KVL, SCR(), it, lane); }
                { IDS(); unsigned char* const ws = KA_WS(); const float* wo = KA_IN(12) + (size_t)lj * DM * DM;
                  for (int it = gw; it < I_O; it += NGW) tr_item<0>(wo, DM, (bf16_t*)(ws + W_O), DM, SCR(), it, lane); }
            }
            { IDS(); unsigned char* const ws = KA_WS(); const float* wg = KA_IN(13) + (size_t)layer * DM * DFF;
              for (int it = gw; it < I_G; it += NGW) tr_item<1>(wg, DFF, (bf16_t*)(ws + W_GU), DM, SCR(), it, lane); }
            { IDS(); unsigned char* const ws = KA_WS(); const float* wu = KA_IN(14) + (size_t)layer * DM * DFF;
              for (int it = gw; it < I_G; it += NGW) tr_item<2>(wu, DFF, (bf16_t*)(ws + W_GU), DM, SCR(), it, lane); }
            { IDS(); unsigned char* const ws = KA_WS(); const float* wd = KA_IN(15) + (size_t)layer * DFF * DM;
              for (int it = gw; it < I_D; it += NGW) tr_item<0>(wd, DM, (bf16_t*)(ws + W_DN), DFF, SCR(), it, lane); }
            if (layer == 0) { IDS(); unsigned char* const ws = KA_WS(); bf16_t* const Hb = (bf16_t*)(ws + WS_H); float* const X = KA_OUT(); const float* norm_mix = KA_IN(2); pg8::u64* const ss0 = (pg8::u64*)(ws + WS_SS);
              f32x4 gn[8];
#pragma unroll
              for (int j = 0; j < 8; ++j) gn[j] = *(const f32x4*)(norm_mix + 4 * lane + 256 * j);
              const float* x_prompt = KA_IN(0); const float* x_sample = KA_IN(1);
              for (int m = gw; m < T_ALL; m += NGW) { const float* src = m < T_PROMPT ? x_prompt + (size_t)m * DM : x_sample + (size_t)(m - T_PROMPT) * DM; prep_row0(src, gn, Hb + (size_t)m * DM, X + (size_t)m * DM, ss0 + m, lane); } }
        }
        GRID_BAR();
        if (!isB) {
            for (int ch = 0; ch < NCHUNK; ++ch) {
                for (int rep = 0; rep < REP_QKV; ++rep)
                { IDS(); unsigned char* const ws = KA_WS();
                  pg8::Gemm g{(const bf16_t*)(ws + WS_H) + (size_t)ch * CHUNK * DM, (const bf16_t*)(ws + W_QKV), CHUNK, NQKV, DM}; pg8::StaticOrder S; S.init(CHUNK, NQKV, G, bx);
                  pg8::EpiBf16 E{(bf16_t*)(ws + S_QKV), NQKV, CHUNK, (const pg8::u64*)(ws + WS_SS) + (size_t)(2 * layer) * T_ALL + (size_t)ch * CHUNK}; pg8::gemm_phase<pg8::EpiBf16, pg8::StaticOrder>(ldsl + RING_OFF, g, S, E, wave0); }
                GRID_BAR();
                { IDS(); unsigned char* const ws = KA_WS(); const bf16_t* const QKV = (const bf16_t*)(ws + S_QKV); bf16_t* const OG = (bf16_t*)(ws + S_OG); float* const LSE = (float*)(ws + S_LSE);
                  const int S_len = ch < 4 ? SEQ_P : SEQ_S, nseq = ch < 4 ? 1 : 2, RN = S_len / 256, per_seq = 3 * NH * RN, nitems = nseq * per_seq;
                  for (int rep = 0; rep < REP_DWA; ++rep)
                  for (int it = vcu; it < nitems; it += G) {
                      const int sq = it / per_seq, r0 = it % per_seq, g = r0 / (NH * RN), r1 = r0 % (NH * RN), h = r1 / RN, rn = r1 % RN;
                      const int dil = g == 0 ? 1 : (g == 1 ? 4 : 16), nb4 = RN / dil;
                      const int res = rn / nb4, n4 = rn % nb4;
                      dwa::item(QKV, OG, LSE, sq * S_len, S_len, g, dil, res, n4 * 4, h, (char*)lds + RING_OFF, wave0); } }
                GRID_BAR();
                for (int rep = 0; rep < REP_THIN; ++rep)
                { IDS(); unsigned char* const ws = KA_WS(); const bf16_t* const OG = (const bf16_t*)(ws + S_OG); const float* const LSE = (const float*)(ws + S_LSE); bf16_t* const OA = (bf16_t*)(ws + S_OA);
                  for (int e = gt; e < CHUNK * (DM / 8); e += NGT) { const int row = e >> 8, c8 = e & 255, h = c8 >> 4;
                    const float l0 = LSE[(row * 3 + 0) * NH + h], l1 = LSE[(row * 3 + 1) * NH + h], l2 = LSE[(row * 3 + 2) * NH + h];
                    const float mx = fmaxf(l0, fmaxf(l1, l2)); float w0 = __builtin_amdgcn_exp2f(l0 - mx), w1 = __builtin_amdgcn_exp2f(l1 - mx), w2 = __builtin_amdgcn_exp2f(l2 - mx);
                    const float inv = 1.f / (w0 + w1 + w2); w0 *= inv; w1 *= inv; w2 *= inv;
                    const u32x4 a0 = *(const u32x4*)(OG + ((size_t)row * 3 + 0) * DM + c8 * 8), a1 = *(const u32x4*)(OG + ((size_t)row * 3 + 1) * DM + c8 * 8), a2 = *(const u32x4*)(OG + ((size_t)row * 3 + 2) * DM + c8 * 8);
                    u32x4 o;
#pragma unroll
                    for (int k = 0; k < 4; ++k) { const float lo = w0 * __uint_as_float(a0[k] << 16) + w1 * __uint_as_float(a1[k] << 16) + w2 * __uint_as_float(a2[k] << 16);
                        const float hi = w0 * __uint_as_float(a0[k] & 0xffff0000u) + w1 * __uint_as_float(a1[k] & 0xffff0000u) + w2 * __uint_as_float(a2[k] & 0xffff0000u); o[k] = cvt_pk_bf16(lo, hi); }
                    *(u32x4*)(OA + ((size_t)ch * CHUNK + row) * DM + c8 * 8) = o; } }
            }
        } else {
            { IDS(); unsigned char* const ws = KA_WS();
              pg8::Gemm g{(const bf16_t*)(ws + WS_H), (const bf16_t*)(ws + W_WA), T_ALL, NA, DM}; pg8::StaticOrder S; S.init(T_ALL, NA, G, bx);
              pg8::EpiF32 E{(float*)(ws + S_A), NA, (const pg8::u64*)(ws + WS_SS) + (size_t)(2 * layer) * T_ALL}; pg8::gemm_phase<pg8::EpiF32, pg8::StaticOrder>(ldsl + RING_OFF, g, S, E, wave0); }
            GRID_BAR();
            for (int rep = 0; rep < REP_THIN; ++rep)
            {
                IDS(); unsigned char* const ws = KA_WS(); const float* const Af = (const float*)(ws + S_A); bf16_t* const CQ = (bf16_t*)(ws + S_CQ); bf16_t* const CKV = (bf16_t*)(ws + S_CKV); bf16_t* const KR = (bf16_t*)(ws + S_KR);
                const float* const tabc = (const float*)(ws + WS_ROPE_C); const float* const tabs = (const float*)(ws + WS_ROPE_S);
                const float* gq = KA_IN(8) + lj * QLR; const float* gkv = KA_IN(9) + lj * KVL;
                f32x4 gs[4];
#pragma unroll
                for (int j = 0; j < 4; ++j) gs[j] = lane < 28 ? *(const f32x4*)(gq + 16 * lane + 4 * j) : (lane < 60 ? *(const f32x4*)(gkv + 16 * (lane - 28) + 4 * j) : (f32x4){1.f, 1.f, 1.f, 1.f});
                for (int m = gw; m < T_ALL; m += NGW) {
                    f32x4 v[4]; float ss = 0.f;
#pragma unroll
                    for (int j = 0; j < 4; ++j) { v[j] = *(const f32x4*)(Af + (size_t)m * NA + 16 * lane + 4 * j); ss += (v[j].x * v[j].x + v[j].y * v[j].y) + (v[j].z * v[j].z + v[j].w * v[j].w); }
                    const float sq = wave_sum(lane < 28 ? ss : 0.f, lane), skv = wave_sum((lane >= 28 && lane < 60) ? ss : 0.f, lane);
                    const float rq = 1.f / sqrtf(sq * (1.f / QLR) + NORM_EPS), rkv = 1.f / sqrtf(skv * (1.f / KVL) + NORM_EPS);
                    f32x4 pv_[4];
#pragma unroll
                    for (int j = 0; j < 4; ++j) { pv_[j].x = shfl_xor_f(v[j].x, 2, lane); pv_[j].y = shfl_xor_f(v[j].y, 2, lane); pv_[j].z = shfl_xor_f(v[j].z, 2, lane); pv_[j].w = shfl_xor_f(v[j].w, 2, lane); }
                    if (lane < 32) { u32x4 w0 = {0u, 0u, 0u, 0u}, w1 = {0u, 0u, 0u, 0u};
                        if (lane < 28) { const f32x4 y0 = (v[0] * rq) * gs[0], y1 = (v[1] * rq) * gs[1], y2 = (v[2] * rq) * gs[2], y3 = (v[3] * rq) * gs[3];
                            w0 = (u32x4){cvt_pk_bf16(y0.x, y0.y), cvt_pk_bf16(y0.z, y0.w), cvt_pk_bf16(y1.x, y1.y), cvt_pk_bf16(y1.z, y1.w)};
                            w1 = (u32x4){cvt_pk_bf16(y2.x, y2.y), cvt_pk_bf16(y2.z, y2.w), cvt_pk_bf16(y3.x, y3.y), cvt_pk_bf16(y3.z, y3.w)}; }
                        *(u32x4*)(CQ + (size_t)m * QLP + 16 * lane) = w0; *(u32x4*)(CQ + (size_t)m * QLP + 16 * lane + 8) = w1; }
                    if (lane >= 28 && lane < 60) { const f32x4 y0 = (v[0] * rkv) * gs[0], y1 = (v[1] * rkv) * gs[1], y2 = (v[2] * rkv) * gs[2], y3 = (v[3] * rkv) * gs[3];
                        const u32x4 w0 = {cvt_pk_bf16(y0.x, y0.y), cvt_pk_bf16(y0.z, y0.w), cvt_pk_bf16(y1.x, y1.y), cvt_pk_bf16(y1.z, y1.w)};
                        const u32x4 w1 = {cvt_pk_bf16(y2.x, y2.y), cvt_pk_bf16(y2.z, y2.w), cvt_pk_bf16(y3.x, y3.y), cvt_pk_bf16(y3.z, y3.w)};
                        *(u32x4*)(CKV + (size_t)m * KVL + 16 * (lane - 28)) = w0; *(u32x4*)(CKV + (size_t)m * KVL + 16 * (lane - 28) + 8) = w1; }
                    if (lane >= 60) { const int pos = row_pos(m), jb = 16 * (lane & 1); const bool is_t2 = lane >= 62;
#pragma unroll
                        for (int q = 0; q < 4; ++q) { const f32x4 c = *(const f32x4*)(tabc + pos * 32 + jb + 4 * q), s = *(const f32x4*)(tabs + pos * 32 + jb + 4 * q);
                            const f32x4 t1 = is_t2 ? pv_[q] : v[q], t2 = is_t2 ? v[q] : pv_[q];
                            const f32x4 o = is_t2 ? (t1 * s + t2 * c) : (t1 * c - t2 * s);
                            u32x2 w; w.x = cvt_pk_bf16(o.x, o.y); w.y = cvt_pk_bf16(o.z, o.w);
                            *(u32x2*)(KR + (size_t)m * 64 + 8 * (4 * (lane & 1) + q) + (is_t2 ? 4 : 0)) = w; } }
                }
            }
            GRID_BAR();
            { IDS(); unsigned char* const ws = KA_WS();
              pg8::Gemm g{(const bf16_t*)(ws + S_CQ), (const bf16_t*)(ws + W_UQ), T_ALL, NQ, QLP}; pg8::StaticOrder S; S.init(T_ALL, NQ, G, bx);
              pg8::EpiQRope E{(bf16_t*)(ws + S_Q), NQ, (const float*)(ws + WS_ROPE_C), (const float*)(ws + WS_ROPE_S), 0}; pg8::gemm_phase<pg8::EpiQRope, pg8::StaticOrder>(ldsl + RING_OFF, g, S, E, wave0); }
            { IDS(); unsigned char* const ws = KA_WS();
              pg8::Gemm g{(const bf16_t*)(ws + S_CKV), (const bf16_t*)(ws + W_UKV), T_ALL, NKV, KVL}; pg8::StaticOrder S; S.init(T_ALL, NKV, G, bx);
              pg8::EpiBf16 E{(bf16_t*)(ws + S_KV), NKV, 0, nullptr}; pg8::gemm_phase<pg8::EpiBf16, pg8::StaticOrder>(ldsl + RING_OFF, g, S, E, wave0); }
            GRID_BAR();
            {
                IDS(); unsigned char* const ws = KA_WS(); const bf16_t* const Qb = (const bf16_t*)(ws + S_Q); const bf16_t* const KVb = (const bf16_t*)(ws + S_KV); const bf16_t* const KR = (const bf16_t*)(ws + S_KR); bf16_t* const Ob = (bf16_t*)(ws + S_OB);
                for (int rep = 0; rep < REP_MLA; ++rep)
                for (int id = vcu; id < 2560; id += G) {
                    int seqrow0, seqlen, h, qb;
                    if (id < 2048) { const int pair = id >> 5; qb = id & 31; h = pair & 15; seqrow0 = (pair >> 4) * SEQ_P; seqlen = SEQ_P; }
                    else { const int i2 = id - 2048, pair = i2 >> 4; qb = i2 & 15; h = pair & 15; seqrow0 = T_PROMPT + (pair >> 4) * SEQ_S; seqlen = SEQ_S; }
                    mla::attn_unit(Qb + (size_t)(seqrow0 + qb * 256) * NQ + h * 192, KVb + (size_t)seqrow0 * NKV + h * 256, KR + (size_t)seqrow0 * 64, KVb + (size_t)seqrow0 * NKV + h * 256 + 128,
                                   Ob + (size_t)(seqrow0 + qb * 256) * DM + h * 128, seqlen, (char*)lds + RING_OFF, wave0); }
            }
        }
        GRID_BAR();
        { IDS(); unsigned char* const ws = KA_WS();
          pg8::Gemm g{(const bf16_t*)(ws + (isB ? S_OB : S_OA)), (const bf16_t*)(ws + W_O), T_ALL, DM, DM}; pg8::StaticOrder S; S.init(T_ALL, DM, G, bx);
          pg8::EpiRes E{KA_OUT(), DM, (bf16_t*)(ws + WS_H), KA_IN(3) + layer * DM, (pg8::u64*)(ws + WS_SS) + (size_t)(2 * layer + 1) * T_ALL};
          pg8::gemm_phase<pg8::EpiRes, pg8::StaticOrder>(ldsl + RING_OFF, g, S, E, wave0); }
        GRID_BAR();
        for (int rep = 0; rep < REP_FFN; ++rep)
        { IDS(); unsigned char* const ws = KA_WS();
          pg8::Gemm g{(const bf16_t*)(ws + WS_H), (const bf16_t*)(ws + W_GU), T_ALL, 2 * DFF, DM}; pg8::StaticOrder S; S.init(T_ALL, 2 * DFF, G, bx);
          pg8::EpiSwiGLU E{(bf16_t*)(ws + S_ACT), DFF, (const pg8::u64*)(ws + WS_SS) + (size_t)(2 * layer + 1) * T_ALL}; pg8::gemm_phase<pg8::EpiSwiGLU, pg8::StaticOrder>(ldsl + RING_OFF, g, S, E, wave0); }
        GRID_BAR();
        { IDS(); unsigned char* const ws = KA_WS();
          pg8::Gemm g{(const bf16_t*)(ws + S_ACT), (const bf16_t*)(ws + W_DN), T_ALL, DM, DFF}; pg8::StaticOrder S; S.init(T_ALL, DM, G, bx);
          pg8::EpiRes E{KA_OUT(), DM, layer < 3 ? (bf16_t*)(ws + WS_H) : nullptr, KA_IN(2) + (layer < 3 ? layer + 1 : 0) * DM, (pg8::u64*)(ws + WS_SS) + (size_t)(2 * layer + 2) * T_ALL};
          pg8::gemm_phase<pg8::EpiRes, pg8::StaticOrder>(ldsl + RING_OFF, g, S, E, wave0); }
        GRID_BAR();
    }
    { IDS(); float* const X = KA_OUT(); const float* norm_final = KA_IN(4);
      f32x4 gn[8];
#pragma unroll
      for (int j = 0; j < 8; ++j) gn[j] = *(const f32x4*)(norm_final + 4 * lane + 256 * j);
      const unsigned dead = __hip_atomic_load((unsigned*)(KA_WS() + WS_CTL) + CW_BAR + XB_TMO, RLX_AGENT);
      for (int m = gw; m < T_ALL; m += NGW) { rms_row_f32(X + (size_t)m * DM, gn, lane);
          if (dead) { const float qn = __builtin_nanf(""); ((GAS f32x4*)(X + (size_t)m * DM))[lane] = (f32x4){qn, qn, qn, qn}; } } }
}

extern "C" void kernel_launch(void* const* d_in, const int* in_sizes, int n_in, void* d_out, int out_size, void* d_ws, size_t ws_size, hipStream_t stream) {
    static int grid = 0;
    if (grid == 0) {
        if (n_in != 16 || out_size != T_ALL * DM || ws_size < WS_END) { fprintf(stderr, "kernel_launch: shape mismatch (n_in %d out %d ws %zu, need ws >= %zu)\n", n_in, out_size, ws_size, (size_t)WS_END); grid = -1; return; }
        int dev = 0, cus = 0, per_cu = 0;
        if (hipGetDevice(&dev) != hipSuccess || hipDeviceGetAttribute(&cus, hipDeviceAttributeMultiprocessorCount, dev) != hipSuccess) { grid = -1; return; }
        if (hipFuncSetAttribute((const void*)fwd, hipFuncAttributeMaxDynamicSharedMemorySize, LDS_BYTES) != hipSuccess) { fprintf(stderr, "kernel_launch: hipFuncSetAttribute failed\n"); grid = -1; return; }
        if (hipOccupancyMaxActiveBlocksPerMultiprocessor(&per_cu, (const void*)fwd, NWAVES * 64, LDS_BYTES) != hipSuccess || per_cu < 1)
            fprintf(stderr, "kernel_launch: occupancy query reports %d workgroups per CU\n", per_cu);
        (void)hipGetLastError();
        if (cus < NBLK) { fprintf(stderr, "kernel_launch: built for %d CUs, device has %d\n", NBLK, cus); grid = -1; return; }
        grid = NBLK;
    }
    if (grid < 0) return;
    if (hipMemsetAsync((char*)d_ws + WS_CTL, 0, CTL_ZERO_BYTES, stream) != hipSuccess) { fprintf(stderr, "kernel_launch: memset failed\n"); return; }
    Args a{};
    for (int i = 0; i < 16; ++i) a.in[i] = (const float*)d_in[i];
    a.out = (float*)d_out; a.ws = (unsigned char*)d_ws;
    hipLaunchKernelGGL(fwd, dim3(grid), dim3(NWAVES * 64), LDS_BYTES, stream, a);
    const hipError_t le = hipPeekAtLastError();
    if (le != hipSuccess) fprintf(stderr, "kernel_launch: launch failed: %s\n", hipGetErrorName(le));
}
```

```cpp
#include <hip/hip_runtime.h>
#include <cstdio>
#include <cstdint>
#ifndef REP_FFN
#define REP_FFN 1
#endif
#ifndef REP_MLA
#define REP_MLA 1
#endif
#ifndef REP_THIN
#define REP_THIN 1
#endif
#ifndef REP_DWA
#define REP_DWA 1
#endif
#ifndef REP_QKV
#define REP_QKV 1
#endif

#define LAS __attribute__((address_space(3)))
#define GAS __attribute__((address_space(1)))
typedef unsigned short bf16_t;
typedef short bf16x8 __attribute__((ext_vector_type(8)));
typedef short s16x4 __attribute__((ext_vector_type(4)));
typedef float f32x4 __attribute__((ext_vector_type(4)));
typedef float f32x2 __attribute__((ext_vector_type(2)));
typedef float f32x16 __attribute__((ext_vector_type(16)));
typedef unsigned u32x4 __attribute__((ext_vector_type(4)));
typedef unsigned u32x2 __attribute__((ext_vector_type(2)));
typedef GAS unsigned gu32;

constexpr int DM = 2048, T_ALL = 40960, T_PROMPT = 32768, SEQ_P = 8192, SEQ_S = 4096;
constexpr int DFF = 5632, NQKV = 18432, NA = 1024, QLR = 448, QLP = 512, KVL = 512, NQ = 3072, NKV = 4096, NH = 16;
constexpr int CHUNK = 8192, NCHUNK = 5;
constexpr float NORM_EPS = 1e-6f;
constexpr float LOG2E = 1.4426950408889634f;

__device__ __forceinline__ int fresh_lane() { int l; asm volatile("v_mbcnt_lo_u32_b32 %0, -1, 0\n\tv_mbcnt_hi_u32_b32 %0, -1, %0" : "=v"(l)); return l; }
__device__ __forceinline__ unsigned cvt_pk_bf16(float lo, float hi) { unsigned r; asm volatile("v_cvt_pk_bf16_f32 %0, %1, %2" : "=v"(r) : "v"(lo), "v"(hi)); return r; }
__device__ __forceinline__ int row_pos(int row) { return row < T_PROMPT ? (row & (SEQ_P - 1)) : (row & (SEQ_S - 1)); }

namespace pg8 {
constexpr int BM = 256, BK = 64, HALF = 128, HTB = HALF * BK * 2, STAGE_BYTES = 8 * HTB, NXCD = 8, WGM = 8;
__host__ __device__ __forceinline__ int lds_byte(int r, int c) { const int st = (r >> 4) * 2 + (c >> 5), rr = r & 15, cc = c & 31, ob = rr * 64 + cc * 2; return st * 1024 + (ob ^ (((ob >> 9) & 1) << 5)); }
__host__ __device__ __forceinline__ void stage_rc(int b, int& R, int& C) { const int st = b / 1024, sb = b % 1024, swz = sb ^ (((sb >> 9) & 1) << 5); R = (st >> 1) * 16 + swz / 64; C = (st & 1) * 32 + (swz % 64) / 2; }
__host__ __device__ __forceinline__ int perm32(int rho) { const int n = rho >> 4, i = rho & 15; return 8 * (i >> 2) + 4 * n + (i & 3); }

struct Unit { int pm, pn; };
struct Gemm { const bf16_t* A; const bf16_t* Bt; int M, N, K; };

struct StaticOrder {
    int nM, nN, nwg, G, c;
    __host__ __device__ void init(int M, int N, int G_, int c_) { nM = M / BM; nN = N / BM; nwg = nM * nN; G = G_; c = c_; }
    __host__ __device__ bool next(int i, Unit& u) const {
        const long L = (long)i * G + c; if (L >= nwg) return false;
        int wgid = (int)L; { const int q = nwg / NXCD, r = nwg % NXCD, xcd = wgid % NXCD, off = wgid / NXCD; wgid = (xcd < r ? xcd * (q + 1) : r * (q + 1) + (xcd - r) * q) + off; }
        const int nig = WGM * nN, gid = wgid / nig, fm = gid * WGM, gsz = (nM - fm) < WGM ? (nM - fm) : WGM;
        u.pm = fm + ((wgid % nig) % gsz); u.pn = (wgid % nig) / gsz; return true;
    }
    __device__ __forceinline__ void a_ready(const Unit&) const {}
    __device__ __forceinline__ void done(const Unit&) const {}
};

typedef unsigned long long u64;
constexpr float SS_SCALE = 1048576.0f, SS_INV = 1.0f / 1048576.0f;
__device__ __forceinline__ float row_rstd(const u64* ss, int row) { return ss ? __builtin_amdgcn_rsqf((float)ss[row] * (SS_INV / DM) + NORM_EPS) : 1.0f; }
struct PreNone { };
struct PreSS { u64 v[2][4]; };
__device__ __forceinline__ void prefetch_ss(PreSS& p, const u64* ss, const Unit& u, int wr, int fr) {
#pragma unroll
    for (int ai = 0; ai < 2; ++ai)
#pragma unroll
        for (int m = 0; m < 4; ++m) p.v[ai][m] = ss ? ss[u.pm * BM + ai * HALF + wr * 64 + m * 16 + fr] : 0ull;
}
__device__ __forceinline__ float pre_rstd(const PreSS& p, const u64* ss, int ai, int m) { return ss ? __builtin_amdgcn_rsqf((float)p.v[ai][m] * (SS_INV / DM) + NORM_EPS) : 1.0f; }
struct EpiBf16 {
    static constexpr bool PERM = true, AFTER_DRAIN = false;
    bf16_t* O; int ldc; int sect_rows; const u64* ss;
    typedef PreSS Pre;
    __device__ __forceinline__ void prefetch(Pre& p, const Unit& u, int wr, int fr) const { prefetch_ss(p, ss, u, wr, fr); }
    __device__ __forceinline__ void operator()(const f32x4 (&acc)[2][2][4][2], const Unit& u, int wr, int wc, int fr, int fq, const Pre& pre) const {
        const int row0 = u.pm * BM + wr * 64 + fr, col0 = u.pn * BM + wc * 32 + 8 * fq;
#pragma unroll
        for (int ai = 0; ai < 2; ++ai)
#pragma unroll
            for (int m = 0; m < 4; ++m) { const int row = row0 + ai * HALF + m * 16; const float rs = pre_rstd(pre, ss, ai, m);
#pragma unroll
                for (int bj = 0; bj < 2; ++bj) { const f32x4 v0 = acc[ai][bj][m][0] * rs, v1 = acc[ai][bj][m][1] * rs;
                    bf16_t* p = sect_rows ? O + ((size_t)(2 * u.pn + bj) * sect_rows + row) * 128 + wc * 32 + 8 * fq : O + (size_t)row * ldc + col0 + bj * HALF;
                    u32x4 w; w.x = cvt_pk_bf16(v0[0], v0[1]); w.y = cvt_pk_bf16(v0[2], v0[3]); w.z = cvt_pk_bf16(v1[0], v1[1]); w.w = cvt_pk_bf16(v1[2], v1[3]);
                    *(u32x4*)p = w; } }
    }
};
struct EpiQRope {
    static constexpr bool PERM = true, AFTER_DRAIN = false;
    bf16_t* O; int ldc; const float* tabc; const float* tabs; int row_base;
    typedef PreNone Pre;
    __device__ __forceinline__ void prefetch(Pre&, const Unit&, int, int) const {}
    __device__ __forceinline__ void operator()(const f32x4 (&acc)[2][2][4][2], const Unit& u, int wr, int wc, int fr, int fq, const Pre&) const {
        const int row0 = u.pm * BM + wr * 64 + fr, col0 = u.pn * BM + wc * 32 + 8 * fq;
#pragma unroll
        for (int bj = 0; bj < 2; ++bj) {
            const int G = u.pn * 8 + bj * 4 + wc, within = G % 6;
            const bool rope = within >= 4; const int j0 = 16 * (within - 4) + 4 * fq;
#pragma unroll
            for (int ai = 0; ai < 2; ++ai)
#pragma unroll
                for (int m = 0; m < 4; ++m) { const int row = row0 + ai * HALF + m * 16; bf16_t* rowp = O + (size_t)row * ldc + col0 + bj * HALF;
                    f32x4 v0 = acc[ai][bj][m][0], v1 = acc[ai][bj][m][1];
                    if (rope) { const int pos = row_pos(row_base + row); const f32x4 c = *(const f32x4*)(tabc + pos * 32 + j0), s = *(const f32x4*)(tabs + pos * 32 + j0);
                        const f32x4 o1 = v0 * c - v1 * s, o2 = v0 * s + v1 * c; v0 = o1; v1 = o2; }
                    u32x4 w; w.x = cvt_pk_bf16(v0[0], v0[1]); w.y = cvt_pk_bf16(v0[2], v0[3]); w.z = cvt_pk_bf16(v1[0], v1[1]); w.w = cvt_pk_bf16(v1[2], v1[3]);
                    *(u32x4*)rowp = w; }
        }
    }
};
struct EpiSwiGLU {
    static constexpr bool PERM = true, AFTER_DRAIN = false;
    bf16_t* O; int ldc; const u64* ss;
    typedef PreSS Pre;
    __device__ __forceinline__ void prefetch(Pre& p, const Unit& u, int wr, int fr) const { prefetch_ss(p, ss, u, wr, fr); }
    __device__ __forceinline__ void operator()(const f32x4 (&acc)[2][2][4][2], const Unit& u, int wr, int wc, int fr, int fq, const Pre& pre) const {
        const int row0 = u.pm * BM + wr * 64 + fr, col0 = u.pn * HALF + wc * 32 + 8 * fq;
#pragma unroll
        for (int ai = 0; ai < 2; ++ai)
#pragma unroll
            for (int m = 0; m < 4; ++m) { const int row = row0 + ai * HALF + m * 16; bf16_t* rowp = O + (size_t)row * ldc + col0; float r[8]; const float rs = pre_rstd(pre, ss, ai, m);
#pragma unroll
                for (int n = 0; n < 2; ++n)
#pragma unroll
                    for (int e = 0; e < 4; ++e) { const float g = acc[ai][0][m][n][e] * rs, up = acc[ai][1][m][n][e] * rs;
                        const float sg = g * __builtin_amdgcn_rcpf(1.0f + __builtin_amdgcn_exp2f(-g * LOG2E)); r[n * 4 + e] = sg * up; }
                u32x4 w; w.x = cvt_pk_bf16(r[0], r[1]); w.y = cvt_pk_bf16(r[2], r[3]); w.z = cvt_pk_bf16(r[4], r[5]); w.w = cvt_pk_bf16(r[6], r[7]);
                *(u32x4*)rowp = w; }
    }
};
struct EpiRes {
    static constexpr bool PERM = true, AFTER_DRAIN = false;
    float* out; int ldc; bf16_t* xg; const float* gain; u64* ss;
    typedef PreNone Pre;
    __device__ __forceinline__ void prefetch(Pre&, const Unit&, int, int) const {}
    __device__ __forceinline__ void operator()(const f32x4 (&acc)[2][2][4][2], const Unit& u, int wr, int wc, int fr, int fq, const Pre&) const {
        const int col0 = u.pn * BM + wc * 32 + 8 * fq, lane = fq * 16 + fr;
        f32x4 g4[2][2];
#pragma unroll
        for (int bj = 0; bj < 2; ++bj)
#pragma unroll
            for (int n = 0; n < 2; ++n) g4[bj][n] = xg ? *(const f32x4*)(gain + col0 + bj * HALF + n * 4) : (f32x4){0.f, 0.f, 0.f, 0.f};
#pragma unroll
        for (int ai = 0; ai < 2; ++ai)
#pragma unroll
            for (int m = 0; m < 4; ++m) { const int row = u.pm * BM + ai * HALF + wr * 64 + m * 16 + fr; float* rowp = out + (size_t)row * ldc + col0;
                f32x4 b[2][2];
#pragma unroll
                for (int bj = 0; bj < 2; ++bj)
#pragma unroll
                    for (int n = 0; n < 2; ++n) b[bj][n] = *(const f32x4*)(rowp + bj * HALF + n * 4);
                float q = 0.f;
#pragma unroll
                for (int bj = 0; bj < 2; ++bj) { const f32x4 x0 = b[bj][0] + acc[ai][bj][m][0], x1 = b[bj][1] + acc[ai][bj][m][1];
                    *(f32x4*)(rowp + bj * HALF) = x0; *(f32x4*)(rowp + bj * HALF + 4) = x1;
                    if (xg) { q += ((x0.x * x0.x + x0.y * x0.y) + (x0.z * x0.z + x0.w * x0.w)) + ((x1.x * x1.x + x1.y * x1.y) + (x1.z * x1.z + x1.w * x1.w));
                        const f32x4 y0 = x0 * g4[bj][0], y1 = x1 * g4[bj][1];
                        u32x4 w; w.x = cvt_pk_bf16(y0.x, y0.y); w.y = cvt_pk_bf16(y0.z, y0.w); w.z = cvt_pk_bf16(y1.x, y1.y); w.w = cvt_pk_bf16(y1.z, y1.w);
                        *(u32x4*)(xg + (size_t)row * ldc + col0 + bj * HALF) = w; } }
                if (xg) { q += __int_as_float(__builtin_amdgcn_ds_bpermute((lane ^ 16) << 2, __float_as_int(q))); q += __int_as_float(__builtin_amdgcn_ds_bpermute((lane ^ 32) << 2, __float_as_int(q)));
                    if (fq == 0) (void)__hip_atomic_fetch_add(ss + row, (u64)(q * SS_SCALE + 0.5f), __ATOMIC_RELAXED, __HIP_MEMORY_SCOPE_AGENT); }
                if (m & 1) asm volatile("" ::: "memory"); }
    }
};
struct EpiF32 {
    static constexpr bool PERM = false, AFTER_DRAIN = false;
    float* out; int ldc; const u64* ss;
    typedef PreSS Pre;
    __device__ __forceinline__ void prefetch(Pre& p, const Unit& u, int wr, int fr) const { prefetch_ss(p, ss, u, wr, fr); }
    __device__ __forceinline__ void operator()(const f32x4 (&acc)[2][2][4][2], const Unit& u, int wr, int wc, int fr, int fq, const Pre& pre) const {
        const int col0 = u.pn * BM + wc * 32 + 4 * fq;
#pragma unroll
        for (int ai = 0; ai < 2; ++ai)
#pragma unroll
            for (int m = 0; m < 4; ++m) { const int row = u.pm * BM + ai * HALF + wr * 64 + m * 16 + fr; float* rowp = out + (size_t)row * ldc + col0; const float rs = pre_rstd(pre, ss, ai, m);
#pragma unroll
                for (int bj = 0; bj < 2; ++bj)
#pragma unroll
                    for (int n = 0; n < 2; ++n) *(f32x4*)(rowp + bj * HALF + n * 16) = acc[ai][bj][m][n] * rs; }
    }
};

template <class Epi, class Sched, bool ALIGN_EPI = true>
__device__ __forceinline__ void gemm_phase(LAS unsigned char* lds, const Gemm g, const Sched& S, const Epi& E, int wave0) {
    const int lane = fresh_lane(), wid = wave0, tid = wid * 64 + lane;
    const int wr = wid >> 2, wc = wid & 3, fr = lane & 15, fq = lane >> 4;
    const int K = g.K, nt = K / BK;
    unsigned voffA[2], voffB[2];
#pragma unroll
    for (int i = 0; i < 2; ++i) { int R, C; stage_rc(tid * 16 + i * 8192, R, C); const int Rb = Epi::PERM ? ((R & ~31) + perm32(R & 31)) : R;
        voffA[i] = (unsigned)(R * K + C) * 2u; voffB[i] = (unsigned)(Rb * K + C) * 2u; }
    const size_t kstep = (size_t)(BK * 2);
    const size_t hstep = (size_t)HALF * K * 2;
    const size_t tstep = 2 * hstep;
    const unsigned ldsw = (unsigned)wid * 1024u;
    const int aoff = lds_byte(wr * 64 + fr, fq * 8), boff = lds_byte(wc * 32 + fr, fq * 8);
#define PG8_SA(b, h) (((b) * 2 + (h)) * HTB)
#define PG8_SB(b, h) ((4 + (b) * 2 + (h)) * HTB)
#define PG8_STAGE(bufoff, gbase, voff) do { _Pragma("unroll") for (int _i = 0; _i < 2; ++_i) \
        __builtin_amdgcn_global_load_lds((const unsigned*)((const char*)(gbase) + (voff)[_i]), (LAS unsigned*)(lds + (bufoff) + ldsw + _i * 8192), 16, 0, 0); } while (0)
#define PG8_LDA(dst, b, h) do { _Pragma("unroll") for (int m = 0; m < 4; ++m) _Pragma("unroll") for (int k = 0; k < 2; ++k) dst[m][k] = *(const LAS bf16x8*)(lds + PG8_SA(b, h) + aoff + m * 2048 + k * 1024); } while (0)
#define PG8_LDB(dst, b, h) do { _Pragma("unroll") for (int n = 0; n < 2; ++n) _Pragma("unroll") for (int k = 0; k < 2; ++k) dst[n][k] = *(const LAS bf16x8*)(lds + PG8_SB(b, h) + boff + n * 2048 + k * 1024); } while (0)
#define PG8_MMA(ai, bj, At, Bt) do { __builtin_amdgcn_s_setprio(1); _Pragma("unroll") for (int m = 0; m < 4; ++m) _Pragma("unroll") for (int n = 0; n < 2; ++n) _Pragma("unroll") for (int k = 0; k < 2; ++k) \
        acc[ai][bj][m][n] = __builtin_amdgcn_mfma_f32_16x16x32_bf16(Bt[n][k], At[m][k], acc[ai][bj][m][n], 0, 0, 0); __builtin_amdgcn_s_setprio(0); } while (0)
#define PG8_WAIT_V(n) asm volatile("s_waitcnt vmcnt(" #n ")" ::: "memory")
#define PG8_WAIT_L(n) asm volatile("s_waitcnt lgkmcnt(" #n ")" ::: "memory")
#define PG8_BAR __builtin_amdgcn_s_barrier()
#define PG8_SCHED __builtin_amdgcn_sched_barrier(0)
    Unit cur, nxt; int ui = 0;
    if (!S.next(0, cur)) return;
    f32x4 acc[2][2][4][2];
#pragma unroll
    for (int a = 0; a < 2; ++a)
#pragma unroll
        for (int b = 0; b < 2; ++b)
#pragma unroll
            for (int m = 0; m < 4; ++m)
#pragma unroll
                for (int n = 0; n < 2; ++n) acc[a][b][m][n] = (f32x4){0.f, 0.f, 0.f, 0.f};
    bf16x8 At[4][2], B0[2][2], B1[2][2];
    const char* cA = (const char*)g.A + (size_t)cur.pm * tstep; const char* cB = (const char*)g.Bt + (size_t)cur.pn * tstep;
    S.a_ready(cur);
    typename Epi::Pre pre; E.prefetch(pre, cur, wr, fr);
    PG8_STAGE(PG8_SB(0, 0), cB, voffB); PG8_STAGE(PG8_SB(0, 1), cB + hstep, voffB); PG8_STAGE(PG8_SA(0, 0), cA, voffA); PG8_STAGE(PG8_SA(0, 1), cA + hstep, voffA);
    if (wr == 1) PG8_BAR;
    PG8_WAIT_V(2); PG8_BAR;
    PG8_STAGE(PG8_SB(1, 0), cB + kstep, voffB); PG8_STAGE(PG8_SA(1, 0), cA + kstep, voffA); PG8_STAGE(PG8_SB(1, 1), cB + hstep + kstep, voffB);
    PG8_WAIT_V(6); PG8_BAR;
    for (;;) {
        const bool has_next = S.next(ui + 1, nxt);
        const char* nA = has_next ? (const char*)g.A + (size_t)nxt.pm * tstep : cA; const char* nB = has_next ? (const char*)g.Bt + (size_t)nxt.pn * tstep : cB;
        for (int t = 0; t < nt; t += 2) {
            const bool last = (t == nt - 2);
            const char* a1 = cA + (size_t)(t + 1) * kstep;
            const char* a2 = last ? nA : cA + (size_t)(t + 2) * kstep; const char* b2 = last ? nB : cB + (size_t)(t + 2) * kstep;
            const char* a3 = a2 + kstep; const char* b3 = b2 + kstep;
            if (last && has_next) S.a_ready(nxt);
            PG8_LDB(B0, 0, 0); PG8_LDB(B1, 0, 1); PG8_SCHED; PG8_LDA(At, 0, 0); PG8_STAGE(PG8_SA(1, 1), a1 + hstep, voffA);
            PG8_WAIT_V(8); PG8_WAIT_L(0); PG8_BAR; PG8_MMA(0, 0, At, B0); PG8_MMA(0, 1, At, B1); PG8_BAR; PG8_SCHED;
            PG8_LDA(At, 0, 1); PG8_STAGE(PG8_SB(0, 0), b2, voffB); PG8_STAGE(PG8_SB(0, 1), b2 + hstep, voffB); PG8_STAGE(PG8_SA(0, 0), a2, voffA);
            PG8_WAIT_V(8); PG8_WAIT_L(0); PG8_BAR; PG8_MMA(1, 0, At, B0); PG8_MMA(1, 1, At, B1); PG8_BAR; PG8_SCHED;
            PG8_LDB(B0, 1, 0); PG8_LDB(B1, 1, 1); PG8_SCHED; PG8_LDA(At, 1, 0); PG8_STAGE(PG8_SA(0, 1), a2 + hstep, voffA);
            PG8_WAIT_V(8); PG8_WAIT_L(0); PG8_BAR; PG8_MMA(0, 0, At, B0); PG8_MMA(0, 1, At, B1); PG8_BAR; PG8_SCHED;
            PG8_LDA(At, 1, 1); PG8_STAGE(PG8_SB(1, 0), b3, voffB); PG8_STAGE(PG8_SB(1, 1), b3 + hstep, voffB); PG8_STAGE(PG8_SA(1, 0), a3, voffA);
            PG8_WAIT_V(8); PG8_WAIT_L(0); PG8_BAR; PG8_MMA(1, 0, At, B0); PG8_MMA(1, 1, At, B1); PG8_BAR; PG8_SCHED;
        }
        if constexpr (ALIGN_EPI) { if (wr == 0) PG8_BAR; }
        E(acc, cur, wr, wc, fr, fq, pre); S.done(cur);
        if (!has_next) break;
#pragma unroll
        for (int a = 0; a < 2; ++a)
#pragma unroll
            for (int b = 0; b < 2; ++b)
#pragma unroll
                for (int m = 0; m < 4; ++m)
#pragma unroll
                    for (int n = 0; n < 2; ++n) acc[a][b][m][n] = (f32x4){0.f, 0.f, 0.f, 0.f};
        cur = nxt; cA = nA; cB = nB; ++ui; E.prefetch(pre, cur, wr, fr);
        if constexpr (ALIGN_EPI) { if (wr == 1) PG8_BAR; }
    }
    PG8_WAIT_V(0);
    if constexpr (!ALIGN_EPI) { if (wr == 0) PG8_BAR; }
    PG8_BAR;
#undef PG8_SA
#undef PG8_SB
#undef PG8_STAGE
#undef PG8_LDA
#undef PG8_LDB
#undef PG8_MMA
#undef PG8_WAIT_V
#undef PG8_WAIT_L
#undef PG8_BAR
#undef PG8_SCHED
}
}

#define SBAR() __builtin_amdgcn_sched_barrier(0)
__device__ __forceinline__ int crow(int r, int hi) { return (r & 3) + 8 * (r >> 2) + 4 * hi; }
__device__ __forceinline__ int v_st(int k, int c) { const int kk = (k & ~0xC) | ((k & 4) << 1) | ((k & 8) >> 1); return ((kk >> 3) * 4 + (c >> 5)) * 512 + ((kk & 7) * 32 + (c & 31)) * 2; }
__device__ __forceinline__ int v_rd_base(int lane) { return ((lane & 3) << 3) | (((lane >> 2) & 3) << 6) | (((lane >> 4) & 1) << 5) | (((lane >> 5) & 1) << 8); }
constexpr int v_rd_off(int d0, int ks, int half) { return d0 * 512 + ks * 4096 + half * 2048; }
template <int OFF> __device__ __forceinline__ s16x4 tr_read(int vb) {
  s16x4 r; asm volatile("ds_read_b64_tr_b16 %0, %1 offset:%2" : "=&v"(r) : "v"(vb), "i"(OFF) : "memory"); return r;
}
template <int D0> __device__ __forceinline__ void pv_one(f32x16& od, int vb, bf16x8 pa0, bf16x8 pa1, bf16x8 pa2, bf16x8 pa3) {
  const s16x4 l0 = tr_read<v_rd_off(D0, 0, 0)>(vb), h0 = tr_read<v_rd_off(D0, 0, 1)>(vb), l1 = tr_read<v_rd_off(D0, 1, 0)>(vb), h1 = tr_read<v_rd_off(D0, 1, 1)>(vb);
  const s16x4 l2 = tr_read<v_rd_off(D0, 2, 0)>(vb), h2 = tr_read<v_rd_off(D0, 2, 1)>(vb), l3 = tr_read<v_rd_off(D0, 3, 0)>(vb), h3 = tr_read<v_rd_off(D0, 3, 1)>(vb);
  asm volatile("s_waitcnt lgkmcnt(0)" ::: "memory"); SBAR();
#define PK(L, H) (bf16x8){L[0], L[1], L[2], L[3], H[0], H[1], H[2], H[3]}
  od = __builtin_amdgcn_mfma_f32_32x32x16_bf16(pa0, PK(l0, h0), od, 0, 0, 0);
  od = __builtin_amdgcn_mfma_f32_32x32x16_bf16(pa1, PK(l1, h1), od, 0, 0, 0);
  od = __builtin_amdgcn_mfma_f32_32x32x16_bf16(pa2, PK(l2, h2), od, 0, 0, 0);
  od = __builtin_amdgcn_mfma_f32_32x32x16_bf16(pa3, PK(l3, h3), od, 0, 0, 0);
#undef PK
}
__device__ __forceinline__ void pv_d0(f32x16* o, int vb, bf16x8 pa0, bf16x8 pa1, bf16x8 pa2, bf16x8 pa3) {
  pv_one<0>(o[0], vb, pa0, pa1, pa2, pa3); pv_one<1>(o[1], vb, pa0, pa1, pa2, pa3); pv_one<2>(o[2], vb, pa0, pa1, pa2, pa3); pv_one<3>(o[3], vb, pa0, pa1, pa2, pa3);
}
#define PK4(P, BASE, OUT) do { unsigned a0 = cvt_pk_bf16(P[BASE + 0], P[BASE + 1]), a1 = cvt_pk_bf16(P[BASE + 2], P[BASE + 3]);   \
    unsigned b0 = cvt_pk_bf16(P[BASE + 4], P[BASE + 5]), b1 = cvt_pk_bf16(P[BASE + 6], P[BASE + 7]);                              \
    auto r0 = __builtin_amdgcn_permlane32_swap(a0, b0, false, false); auto r1 = __builtin_amdgcn_permlane32_swap(a1, b1, false, false); \
    u32x4 w = {r0[0], r1[0], r0[1], r1[1]}; OUT = *reinterpret_cast<bf16x8*>(&w); } while (0)
__device__ __forceinline__ float half_swap_max(float v) { auto rr = __builtin_amdgcn_permlane32_swap(__float_as_uint(v), __float_as_uint(v), false, false); return fmaxf(__uint_as_float(rr[0]), __uint_as_float(rr[1])); }
__device__ __forceinline__ float half_swap_add(float v) { auto rr = __builtin_amdgcn_permlane32_swap(__float_as_uint(v), __float_as_uint(v), false, false); return __uint_as_float(rr[0]) + __uint_as_float(rr[1]); }

namespace dwa {
constexpr int SLOT = 32768;
constexpr int OFF_WS = 2 * SLOT, LDS_BYTES = OFF_WS + 8 * 256;
constexpr float C_QK = 0.08838834764831845f * LOG2E;
#define KSWZ128(row, colB) ((row) * 256 + ((colB) ^ (((row) & 7) << 4)))
__device__ __forceinline__ void item(const bf16_t* __restrict__ qkvs, bf16_t* __restrict__ og, float* __restrict__ lse, int seqbase, int S, int g, int dil, int res, int n0, int h, char* lds, int wave0) {
  const int lane = fresh_lane(), wid = wave0, tid = wid * 64 + lane, r32 = lane & 31, hi = lane >> 5;
  const int b = wid >> 1, qh = wid & 1;
  const int nblk = (S / dil) >> 6;
  const bf16_t* Qs = qkvs + ((size_t)((g * 3 + 0) * NH + h) * CHUNK + seqbase) * 128;
  const bf16_t* Ks = qkvs + ((size_t)((g * 3 + 1) * NH + h) * CHUNK + seqbase) * 128;
  const bf16_t* Vs = qkvs + ((size_t)((g * 3 + 2) * NH + h) * CHUNK + seqbase) * 128;
  const int a = 32 * qh + r32;
  const long qtok = (long)(64 * (n0 + b) + a) * dil + res;
  bf16x8 qr[8];
#pragma unroll
  for (int d0 = 0; d0 < 8; ++d0) qr[d0] = *(const bf16x8*)(Qs + qtok * 128 + d0 * 16 + hi * 8);
  float* al_l = (float*)(lds + OFF_WS + wid * 256);
  const int sr = tid >> 4, sc = (tid & 15) * 8, vst0 = v_st(sr, sc), vst1 = v_st(32 + sr, sc);
  const int vrd = v_rd_base(lane);
  float m_reg = -1e30f, l_reg = 0.f; f32x16 o[4] = {};
  const float slope2 = __builtin_amdgcn_exp2f(-0.5f * (float)(h + 1)) * (float)dil * LOG2E;
  const int t_lo = (n0 == 0) ? 1 : 0, t_hi = (n0 + 4 >= nblk) ? 4 : 5;
  bf16x8 ks0, ks1, vs0, vs1;
#define DW_SLOAD(t) do { const long k0_ = (long)(64 * (n0 - 1 + (t)) + sr) * dil + res, k1_ = k0_ + (long)32 * dil; \
    ks0 = *(const bf16x8*)(Ks + k0_ * 128 + sc); ks1 = *(const bf16x8*)(Ks + k1_ * 128 + sc); vs0 = *(const bf16x8*)(Vs + k0_ * 128 + sc); vs1 = *(const bf16x8*)(Vs + k1_ * 128 + sc); } while (0)
#define DW_SWRITE(slot) do { char* s_ = lds + (slot) * SLOT; *(bf16x8*)(s_ + KSWZ128(sr, sc * 2)) = ks0; *(bf16x8*)(s_ + KSWZ128(32 + sr, sc * 2)) = ks1; \
    *(bf16x8*)(s_ + 16384 + vst0) = vs0; *(bf16x8*)(s_ + 16384 + vst1) = vs1; } while (0)
  DW_SLOAD(t_lo); asm volatile("s_waitcnt vmcnt(0)" ::: "memory"); DW_SWRITE(t_lo & 1); __syncthreads();
  for (int t = t_lo; t <= t_hi; ++t) {
    if (t < t_hi) DW_SLOAD(t + 1);
    if (b <= t && t <= b + 2) {
      const int kt = t - b - 1; const char* Kt = lds + (t & 1) * SLOT;
      f32x16 p0 = {}, p1 = {};
#pragma unroll
      for (int d0 = 0; d0 < 8; ++d0) { const int cb = (d0 * 16 + hi * 8) * 2;
        const bf16x8 b0 = *reinterpret_cast<const bf16x8*>(Kt + KSWZ128(r32, cb)), b1 = *reinterpret_cast<const bf16x8*>(Kt + KSWZ128(32 + r32, cb));
        p0 = __builtin_amdgcn_mfma_f32_32x32x16_bf16(b0, qr[d0], p0, 0, 0, 0); p1 = __builtin_amdgcn_mfma_f32_32x32x16_bf16(b1, qr[d0], p1, 0, 0, 0); }
      float pmax = -1e30f;
#pragma unroll
      for (int rr = 0; rr < 16; ++rr) { const int rel0 = a - crow(rr, hi) - 64 * kt, rel1 = rel0 - 32; const int ar0 = rel0 < 0 ? -rel0 : rel0, ar1 = rel1 < 0 ? -rel1 : rel1;
        p0[rr] = ar0 <= 64 ? fmaf(p0[rr], C_QK, -slope2 * (float)ar0) : -1e30f; p1[rr] = ar1 <= 64 ? fmaf(p1[rr], C_QK, -slope2 * (float)ar1) : -1e30f;
        pmax = fmaxf(pmax, fmaxf(p0[rr], p1[rr])); }
      pmax = half_swap_max(pmax);
      const float mn = fmaxf(m_reg, pmax), alpha = __builtin_amdgcn_exp2f(m_reg - mn); m_reg = mn;
      float ps = 0.f;
#pragma unroll
      for (int rr = 0; rr < 16; ++rr) { p0[rr] = __builtin_amdgcn_exp2f(p0[rr] - mn); p1[rr] = __builtin_amdgcn_exp2f(p1[rr] - mn); ps += p0[rr] + p1[rr]; }
      ps = half_swap_add(ps); l_reg = l_reg * alpha + ps;
      bf16x8 pa0, pa1, pa2, pa3; PK4(p0, 0, pa0); PK4(p0, 8, pa1); PK4(p1, 0, pa2); PK4(p1, 8, pa3);
      if (hi == 0) al_l[r32] = alpha; asm volatile("s_waitcnt lgkmcnt(0)" ::: "memory");
#pragma unroll
      for (int rr = 0; rr < 16; ++rr) { const float al = al_l[crow(rr, hi)];
#pragma unroll
        for (int d = 0; d < 4; ++d) o[d][rr] *= al; }
      asm volatile("s_waitcnt lgkmcnt(0)" ::: "memory");
      SBAR();
      pv_d0(o, (int)(uintptr_t)(lds + (t & 1) * SLOT + 16384) + vrd, pa0, pa1, pa2, pa3);
    }
    if (t < t_hi) { asm volatile("s_waitcnt vmcnt(0)" ::: "memory"); DW_SWRITE((t + 1) & 1); }
    __syncthreads();
  }
#undef DW_SLOAD
#undef DW_SWRITE
  if (hi == 0) al_l[r32] = __builtin_amdgcn_rcpf(l_reg); asm volatile("s_waitcnt lgkmcnt(0)" ::: "memory");
  bf16_t* stg = (bf16_t*)(lds + wid * 8192);
#pragma unroll
  for (int rr = 0; rr < 16; ++rr) { const int row = crow(rr, hi); const float li = al_l[row];
#pragma unroll
    for (int d = 0; d < 4; ++d) { const unsigned w = cvt_pk_bf16(o[d][rr] * li, 0.f); stg[row * 128 + d * 32 + r32] = (bf16_t)(w & 0xffffu); } }
  asm volatile("s_waitcnt lgkmcnt(0)" ::: "memory");
  const int er = lane >> 4, ec = (lane & 15) * 8;
#pragma unroll
  for (int i = 0; i < 8; ++i) { const int row = er + 4 * i; const long tok = seqbase + (long)(64 * (n0 + b) + 32 * qh + row) * dil + res;
    *(u32x4*)(og + (tok * 3 + g) * DM + h * 128 + ec) = *(const u32x4*)(stg + row * 128 + ec); }
  if (hi == 0) lse[((seqbase + qtok) * 3 + g) * NH + h] = m_reg + __builtin_amdgcn_logf(l_reg);
  asm volatile("s_waitcnt lgkmcnt(0)" ::: "memory");
  __syncthreads();
}
}

namespace mla {
constexpr int NW = 8, QBLK = 32, KVBLK = 64;
constexpr float SCALE = 0.07216878364870322f;
constexpr float THR = 8.f;
constexpr int LDQ = NQ, LDKV = NKV, LDKR = 64, LDO = DM;
constexpr int SHM_V = KVBLK * 128 * 2, SHM_K = KVBLK * 192 * 2;
constexpr int OFF_V = 0, OFF_K = 2 * SHM_V, OFF_WS = 2 * SHM_V + 2 * SHM_K, OFF_QR = OFF_WS + NW * 64 * 4, LDS_BYTES = OFF_QR + NW * 4096;
#define KSWZ192(row, colB) ((row) * 384 + ((colB) ^ (((row) & 7) << 4)))

__device__ __forceinline__ void partialSM(f32x16& p0, f32x16& p1, float& m_reg, float& mn, float& alpha) {
  constexpr float C = SCALE * LOG2E;
  float pmax = p0[0];
#pragma unroll
  for (int r = 1; r < 16; ++r) pmax = fmaxf(pmax, p0[r]);
#pragma unroll
  for (int r = 0; r < 16; ++r) pmax = fmaxf(pmax, p1[r]);
  pmax = half_swap_max(pmax);
  if (__builtin_expect(__all(pmax - m_reg <= THR / SCALE), 1)) { mn = m_reg; alpha = 1.f; }
  else { mn = fmaxf(m_reg, pmax); alpha = __builtin_amdgcn_exp2f((m_reg - mn) * C); m_reg = mn; }
  const float mnC = -mn * C;
#pragma unroll
  for (int r = 0; r < 16; ++r) p0[r] = fmaf(p0[r], C, mnC);
#pragma unroll
  for (int r = 0; r < 16; ++r) p1[r] = fmaf(p1[r], C, mnC);
#pragma unroll
  for (int r = 0; r < 16; ++r) p0[r] = __builtin_amdgcn_exp2f(p0[r]);
}
__device__ __forceinline__ void finishSM(f32x16& p0, f32x16& p1, float alpha, float& l_reg, bf16x8& pa0, bf16x8& pa1, bf16x8& pa2, bf16x8& pa3) {
#pragma unroll
  for (int r = 0; r < 16; ++r) p1[r] = __builtin_amdgcn_exp2f(p1[r]);
  float ps = 0;
#pragma unroll
  for (int r = 0; r < 16; ++r) ps += p0[r];
#pragma unroll
  for (int r = 0; r < 16; ++r) ps += p1[r];
  ps = half_swap_add(ps);
  l_reg = l_reg * alpha + ps;
  PK4(p0, 0, pa0); PK4(p0, 8, pa1); PK4(p1, 0, pa2); PK4(p1, 8, pa3);
}
__device__ __forceinline__ void qkt(f32x16& p0, f32x16& p1, const char* Ks, const bf16x8* qr, const char* qrl, int r32, int hi) {
  p0 = f32x16{}; p1 = f32x16{};
#pragma unroll
  for (int d0 = 0; d0 < 12; ++d0) { const int cb = (d0 * 16 + hi * 8) * 2;
    const bf16x8 b0 = *reinterpret_cast<const bf16x8*>(Ks + KSWZ192(r32, cb));
    const bf16x8 b1 = *reinterpret_cast<const bf16x8*>(Ks + KSWZ192(32 + r32, cb));
    const bf16x8 qf = d0 < 8 ? qr[d0 < 8 ? d0 : 0] : *reinterpret_cast<const bf16x8*>(qrl + (d0 - 8) * 1024);
    p0 = __builtin_amdgcn_mfma_f32_32x32x16_bf16(b0, qf, p0, 0, 0, 0);
    p1 = __builtin_amdgcn_mfma_f32_32x32x16_bf16(b1, qf, p1, 0, 0, 0); }
}
__device__ __forceinline__ void attn_unit(const bf16_t* __restrict__ Qb, const bf16_t* __restrict__ Kn, const bf16_t* __restrict__ Kr, const bf16_t* __restrict__ Vh, bf16_t* __restrict__ Ob, int seq, char* lds, int wave0) {
  const int lane = fresh_lane(), wid = wave0, tid = wid * 64 + lane, r32 = lane & 31, hi = lane >> 5;
  char* V_lds = lds + OFF_V; char* K_lds = lds + OFF_K;
  float* ws = (float*)(lds + OFF_WS) + wid * 64; float* li_l = ws; float* al_l = ws + 32;
  float m_reg = -1e30f, l_reg = 0; f32x16 o[4] = {}; bf16x8 qr[8];
  const bf16_t* Qw = Qb + (long)(wid * QBLK + r32) * LDQ + hi * 8;
#pragma unroll
  for (int d0 = 0; d0 < 8; ++d0) qr[d0] = *reinterpret_cast<const bf16x8*>(Qw + d0 * 16);
  char* const qrl = lds + OFF_QR + wid * 4096 + lane * 16;
#pragma unroll
  for (int d0 = 0; d0 < 4; ++d0) *reinterpret_cast<bf16x8*>(qrl + d0 * 1024) = *reinterpret_cast<const bf16x8*>(Qw + (8 + d0) * 16);
  const int sr = tid >> 4, sc = (tid & 15) * 8, vst0 = v_st(sr, sc), vst1 = v_st(32 + sr, sc);
  const int rr_ = tid >> 3, rc = (tid & 7) * 8;
  const int vb0 = (int)(uintptr_t)V_lds + v_rd_base(lane);
  struct { bf16x8 vs0, vs1, ks0, ks1, kr; } sr_[1];
#define SLOAD(i, k0) do { sr_[i].vs0 = *reinterpret_cast<const bf16x8*>(&Vh[(long)((k0) + sr) * LDKV + sc]); sr_[i].vs1 = *reinterpret_cast<const bf16x8*>(&Vh[(long)((k0) + 32 + sr) * LDKV + sc]); \
    sr_[i].ks0 = *reinterpret_cast<const bf16x8*>(&Kn[(long)((k0) + sr) * LDKV + sc]); sr_[i].ks1 = *reinterpret_cast<const bf16x8*>(&Kn[(long)((k0) + 32 + sr) * LDKV + sc]); \
    sr_[i].kr = *reinterpret_cast<const bf16x8*>(&Kr[(long)((k0) + rr_) * LDKR + rc]); } while (0)
#define SWRITE(b, i) do { *(bf16x8*)(V_lds + (b) * SHM_V + vst0) = sr_[i].vs0; *(bf16x8*)(V_lds + (b) * SHM_V + vst1) = sr_[i].vs1; const int kc = sc * 2; \
    *(bf16x8*)(K_lds + (b) * SHM_K + KSWZ192(sr, kc)) = sr_[i].ks0; *(bf16x8*)(K_lds + (b) * SHM_K + KSWZ192(32 + sr, kc)) = sr_[i].ks1; \
    *(bf16x8*)(K_lds + (b) * SHM_K + KSWZ192(rr_, 256 + rc * 2)) = sr_[i].kr; } while (0)
#define SWAIT() asm volatile("s_waitcnt vmcnt(0)" ::: "memory")
#define RESC(a) do { if (__any((a) < 1.f)) { if (hi == 0) al_l[r32] = (a); asm volatile("s_waitcnt lgkmcnt(0)" ::: "memory"); \
    _Pragma("unroll") for (int d = 0; d < 4; ++d) _Pragma("unroll") for (int r = 0; r < 16; ++r) o[d][r] *= al_l[crow(r, hi)]; } } while (0)
  f32x16 pA0, pA1, pB0, pB1; float mnA, mnB, alA, alB; bf16x8 pa0, pa1, pa2, pa3; const int NT = seq / KVBLK;
  constexpr int SE = 0, SO = 0;
  SLOAD(SE, 0); asm volatile("s_waitcnt vmcnt(0)" ::: "memory"); SWRITE(0, SE); __syncthreads();
  qkt(pA0, pA1, K_lds, qr, qrl, r32, hi); partialSM(pA0, pA1, m_reg, mnA, alA);
  SLOAD(SO, KVBLK);
  SWAIT(); SWRITE(1, SO); __syncthreads();
  for (int j = 1; j + 1 < NT; j += 2) {
    SBAR(); qkt(pB0, pB1, K_lds + SHM_K, qr, qrl, r32, hi);
    finishSM(pA0, pA1, alA, l_reg, pa0, pa1, pa2, pa3); SBAR();
    SLOAD(SE, (j + 1) * KVBLK); SBAR();
    pv_d0(o, vb0, pa0, pa1, pa2, pa3); partialSM(pB0, pB1, m_reg, mnB, alB);
    __syncthreads(); SWAIT(); SWRITE(0, SE);
    RESC(alB); __syncthreads();
    SBAR(); qkt(pA0, pA1, K_lds, qr, qrl, r32, hi);
    finishSM(pB0, pB1, alB, l_reg, pa0, pa1, pa2, pa3); SBAR();
    SLOAD(SO, (j + 2) * KVBLK); SBAR();
    pv_d0(o, vb0 + SHM_V, pa0, pa1, pa2, pa3); partialSM(pA0, pA1, m_reg, mnA, alA);
    __syncthreads(); SWAIT(); SWRITE(1, SO);
    RESC(alA); __syncthreads();
  }
  SBAR(); qkt(pB0, pB1, K_lds + SHM_K, qr, qrl, r32, hi);
  finishSM(pA0, pA1, alA, l_reg, pa0, pa1, pa2, pa3); SBAR();
  pv_d0(o, vb0, pa0, pa1, pa2, pa3); partialSM(pB0, pB1, m_reg, mnB, alB);
  __syncthreads(); RESC(alB);
  finishSM(pB0, pB1, alB, l_reg, pa0, pa1, pa2, pa3); SBAR();
  pv_d0(o, vb0 + SHM_V, pa0, pa1, pa2, pa3);
  if (hi == 0) li_l[r32] = l_reg; asm volatile("s_waitcnt lgkmcnt(0)" ::: "memory");
  __syncthreads();
  bf16_t* stg = (bf16_t*)(lds + OFF_V + wid * 8192);
#pragma unroll
  for (int r = 0; r < 16; ++r) { const int row = crow(r, hi); const float li = __builtin_amdgcn_rcpf(li_l[row]);
#pragma unroll
    for (int d = 0; d < 4; ++d) { const unsigned w = cvt_pk_bf16(o[d][r] * li, 0.f); stg[row * 128 + d * 32 + r32] = (bf16_t)(w & 0xffffu); } }
  asm volatile("s_waitcnt lgkmcnt(0)" ::: "memory");
  const int er = lane >> 4, ec = (lane & 15) * 8;
#pragma unroll
  for (int i = 0; i < 8; ++i) { const int row = er + 4 * i;
    *(u32x4*)(Ob + (long)(wid * QBLK + row) * LDO + ec) = *(const u32x4*)(stg + row * 128 + ec); }
  asm volatile("s_waitcnt lgkmcnt(0)" ::: "memory");
  __syncthreads();
#undef SLOAD
#undef SWRITE
#undef SWAIT
#undef RESC
}
}

constexpr int NWAVES = 8;
constexpr int NBLK = 256;
constexpr size_t MiB = 1u << 20;
constexpr size_t WS_CTL = 0, WS_SS = 1 * MiB, CTL_ZERO_BYTES = 4 * MiB;
constexpr size_t WS_ROPE_C = 150 * MiB, WS_ROPE_S = 151 * MiB;
constexpr size_t WS_W = 4 * MiB;
constexpr size_t W_QKV = WS_W, W_WA = WS_W, W_UQ = WS_W + 4 * MiB, W_UKV = WS_W + 8 * MiB;
constexpr size_t W_O = WS_W + 72 * MiB, W_GU = WS_W + 80 * MiB, W_DN = WS_W + 124 * MiB;
constexpr size_t WS_H = 152 * MiB;
constexpr size_t WS_S = 312 * MiB;
constexpr size_t S_QKV = WS_S, S_OG = WS_S + 288 * MiB, S_LSE = WS_S + 384 * MiB, S_OA = WS_S + 386 * MiB;
constexpr size_t S_ACT = WS_S;
constexpr size_t S_KV = WS_S, S_A = WS_S, S_CQ = WS_S + 320 * MiB, S_CKV = WS_S + 360 * MiB, S_KR = WS_S + 400 * MiB, S_Q = WS_S + 405 * MiB, S_OB = WS_S + 645 * MiB;
constexpr size_t WS_END = WS_S + 805 * MiB;
static_assert(S_OA + (size_t)T_ALL * DM * 2 <= WS_END && S_Q + (size_t)T_ALL * NQ * 2 <= S_OB && S_OB + (size_t)T_ALL * DM * 2 <= WS_END && S_ACT + (size_t)T_ALL * DFF * 2 <= WS_END, "d_ws map");
static_assert(W_DN + (size_t)DM * DFF * 2 <= WS_H && W_QKV + (size_t)NQKV * DM * 2 <= W_O && WS_H + (size_t)T_ALL * DM * 2 <= WS_S && WS_SS + (size_t)9 * T_ALL * 8 <= CTL_ZERO_BYTES && W_DN + (size_t)DM * DFF * 2 <= WS_ROPE_C, "d_ws map");
constexpr int CW_TMO = 0, CW_CODE = 1, CW_BAR = 4096;

constexpr int RING_OFF = 0, RING_BYTES = 146432;
constexpr int LDSCTL_OFF = RING_BYTES, MISC_OFF = LDSCTL_OFF + 320;
constexpr int LDS_BYTES = 147456;
static_assert(MISC_OFF + 128 <= LDS_BYTES && dwa::LDS_BYTES <= RING_BYTES && mla::LDS_BYTES <= RING_BYTES && pg8::STAGE_BYTES <= RING_BYTES, "LDS map");

#define RLX_AGENT __ATOMIC_RELAXED, __HIP_MEMORY_SCOPE_AGENT
#define LDS_WAIT() asm volatile("s_waitcnt lgkmcnt(0)" ::: "memory")
#define VM_WAIT() asm volatile("s_waitcnt vmcnt(0)" ::: "memory")
__device__ __forceinline__ unsigned f2bf(float f) { unsigned u = __builtin_bit_cast(unsigned, f); return (u + 0x7fffu + ((u >> 16) & 1u)) >> 16; }
__device__ __forceinline__ unsigned pk2(float lo, float hi) { return f2bf(lo) | (f2bf(hi) << 16); }

#define XB_TMO      128
#define XB_XCNT(j)  (256  + 64 * (j))
#define XB_XSUB(j)  (1280 + 64 * (j))
#define XB_XGEN(j)  (2304 + 64 * (j))
#define XB_TOP      3328
#define XB_TOPGEN   3392
#define XCD_BAR_WORDS 3456
#define XB_SPIN_CAP (1u << 18)
__device__ __forceinline__ unsigned xb_ld(unsigned* p)              { return __hip_atomic_load(p, __ATOMIC_RELAXED, __HIP_MEMORY_SCOPE_AGENT); }
__device__ __forceinline__ unsigned xb_add(unsigned* p, unsigned v) { return __hip_atomic_fetch_add(p, v, __ATOMIC_RELAXED, __HIP_MEMORY_SCOPE_AGENT); }
__device__ __forceinline__ unsigned xb_xcc_id() { return (unsigned)__builtin_amdgcn_s_getreg((3 << 11) | 20) & 0xFu; }
#define XB_SPIN(cond, bar) do { unsigned _sp = 0; while (cond) { __builtin_amdgcn_s_sleep(1); \
    if ((++_sp & 255u) == 0u) { if (xb_ld(&(bar)[XB_TMO])) break; if (_sp > XB_SPIN_CAP) { atomicAdd(&(bar)[XB_TMO], 1u); break; } } } } while (0)
struct XcdBarrier { unsigned* bar; unsigned x; volatile LAS unsigned* st; bool leader; };
__device__ __forceinline__ XcdBarrier xcd_barrier_post(unsigned* bar, volatile LAS unsigned* st) {
    XcdBarrier b; b.bar = bar; b.x = xb_xcc_id(); b.st = st; b.leader = threadIdx.x == 0;
    if (b.leader) (void)xb_add(&bar[XB_XCNT(b.x)], 1u);
    return b;
}
__device__ __forceinline__ void xcd_barrier_complete(unsigned* bar, unsigned x, unsigned& nloc, unsigned& nx) {
    const unsigned G = gridDim.x * gridDim.y * gridDim.z;
    unsigned sum, cnt, mine, sp = 0u;
    for (;;) {
        sum = 0u; cnt = 0u; mine = 0u;
#pragma unroll
        for (unsigned j = 0; j < 16; ++j) { const unsigned c = xb_ld(&bar[XB_XCNT(j)]); sum += c; cnt += (c > 0u) ? 1u : 0u; mine = (j == x) ? c : mine; }
        if (sum == G) break;
        __builtin_amdgcn_s_sleep(1);
        if ((++sp & 255u) == 0u) { if (xb_ld(&bar[XB_TMO])) break; if (sp > XB_SPIN_CAP) { atomicAdd(&bar[XB_TMO], 1u); break; } }
    }
    nloc = mine > 0u ? mine : 1u; nx = cnt > 0u ? cnt : 1u;
}
__device__ __forceinline__ void xcd_barrier(const XcdBarrier& b) {
    asm volatile("s_waitcnt vmcnt(0)" ::: "memory");
    __syncthreads();
    if (b.leader) {
        unsigned* bar = b.bar;
        __builtin_amdgcn_s_waitcnt(0);
        unsigned nloc = b.st[0], nx = b.st[1];
        if (nloc == 0u) { xcd_barrier_complete(bar, b.x, nloc, nx); b.st[0] = nloc; b.st[1] = nx; }
        const unsigned old = xb_add(&bar[XB_XSUB(b.x)], 1u);
        const unsigned gen = old / nloc;
        if (old + 1u == (gen + 1u) * nloc) {
            __builtin_amdgcn_fence(__ATOMIC_RELEASE, "agent");
            asm volatile("s_waitcnt vmcnt(0)" ::: "memory");
            const unsigned og = xb_add(&bar[XB_TOP], 1u);
            const unsigned tg = og / nx;
            if (og + 1u == (tg + 1u) * nx) xb_add(&bar[XB_TOPGEN], 1u);
            else XB_SPIN(xb_ld(&bar[XB_TOPGEN]) == tg, bar);
            __builtin_amdgcn_fence(__ATOMIC_ACQUIRE, "agent");
            xb_add(&bar[XB_XGEN(b.x)], 1u);
            asm volatile("s_waitcnt vmcnt(0)" ::: "memory");
        } else {
            XB_SPIN(xb_ld(&bar[XB_XGEN(b.x)]) == gen, bar);
            __builtin_amdgcn_fence(__ATOMIC_ACQUIRE, "agent");
            asm volatile("s_waitcnt vmcnt(0)" ::: "memory");
        }
    }
    __syncthreads();
}

__device__ __forceinline__ float shfl_xor_f(float v, int o, int lane) { return __int_as_float(__builtin_amdgcn_ds_bpermute((lane ^ o) << 2, __float_as_int(v))); }
__device__ __forceinline__ float wave_sum(float v, int lane) {
#pragma unroll
    for (int o = 1; o < 64; o <<= 1) v += shfl_xor_f(v, o, lane);
    return v;
}
template <int MODE> __device__ __forceinline__ int wmap(int c) {
    if (MODE == 1) return 256 * (c >> 7) + (c & 127);
    if (MODE == 2) return 256 * (c >> 7) + 128 + (c & 127);
    if (MODE == 3) { const int h = c / 192, w = c % 192; if (w < 128) return c; int j = w - 128;
        if (j < 32) return h * 192 + 128 + 8 * (j >> 2) + (j & 3); j -= 32; return h * 192 + 128 + 8 * (j >> 2) + 4 + (j & 3); }
    return c;
}
template <int MODE> __device__ __forceinline__ void tr_item(const float* __restrict__ W, int N, bf16_t* __restrict__ WT, int Kd, LAS float* scr, int item, int lane) {
    const int nblk = N / 32, kb = item / nblk, nb = item % nblk, k0 = 64 * kb, n0 = 32 * nb;
#pragma unroll 8
    for (int i = 0; i < 32; ++i) { const int kk = 2 * i + (lane >> 5); scr[kk * 33 + (lane & 31)] = W[(size_t)(k0 + kk) * N + n0 + (lane & 31)]; }
    LDS_WAIT(); asm volatile("" ::: "memory");
    const int c = lane & 7;
#pragma unroll
    for (int j = 0; j < 4; ++j) { const int n = (lane >> 3) + 8 * j; const LAS float* s = scr + (8 * c) * 33 + n;
        u32x4 o; o.x = pk2(s[0 * 33], s[1 * 33]); o.y = pk2(s[2 * 33], s[3 * 33]); o.z = pk2(s[4 * 33], s[5 * 33]); o.w = pk2(s[6 * 33], s[7 * 33]);
        *(GAS u32x4*)(WT + (size_t)wmap<MODE>(n0 + n) * Kd + k0 + 8 * c) = o; }
    LDS_WAIT(); asm volatile("" ::: "memory");
}
__device__ __forceinline__ void prep_row0(const float* __restrict__ xrow, const f32x4 (&g)[8], bf16_t* __restrict__ orow, float* __restrict__ copy_row, pg8::u64* __restrict__ ssp, int lane) {
    const GAS f32x4* xr = (const GAS f32x4*)xrow + lane;
    f32x4 v[8]; float s = 0.f;
#pragma unroll
    for (int j = 0; j < 8; ++j) { v[j] = xr[64 * j]; s += (v[j].x * v[j].x + v[j].y * v[j].y) + (v[j].z * v[j].z + v[j].w * v[j].w); }
    s = wave_sum(s, lane);
    if (lane == 0) *ssp = (pg8::u64)(s * pg8::SS_SCALE + 0.5f);
    GAS f32x4* cr = (GAS f32x4*)copy_row + lane;
#pragma unroll
    for (int j = 0; j < 8; ++j) cr[64 * j] = v[j];
    GAS u32x2* o8 = (GAS u32x2*)orow + lane;
#pragma unroll
    for (int j = 0; j < 8; ++j) { const f32x4 y = v[j] * g[j]; u32x2 w; w.x = cvt_pk_bf16(y.x, y.y); w.y = cvt_pk_bf16(y.z, y.w); o8[64 * j] = w; }
}
__device__ __forceinline__ void rms_row_f32(float* __restrict__ xrow, const f32x4 (&g)[8], int lane) {
    GAS f32x4* xr = (GAS f32x4*)xrow + lane;
    f32x4 v[8]; float s = 0.f;
#pragma unroll
    for (int j = 0; j < 8; ++j) { v[j] = xr[64 * j]; s += (v[j].x * v[j].x + v[j].y * v[j].y) + (v[j].z * v[j].z + v[j].w * v[j].w); }
    const float rstd = 1.f / sqrtf(wave_sum(s, lane) * (1.f / DM) + NORM_EPS);
#pragma unroll
    for (int j = 0; j < 8; ++j) xr[64 * j] = (v[j] * rstd) * g[j];
}
__device__ __forceinline__ void sincos_d(double x, double& s, double& c) {
    const double q = __builtin_rint(x * 0.63661977236758134308);
    double y = __builtin_fma(-q, 1.57079632679489655800e+00, x); y = __builtin_fma(-q, 6.12323399573676603587e-17, y);
    const int qi = (int)q; const double y2 = y * y;
    const double sp = y * (1.0 + y2 * (-1.0 / 6.0 + y2 * (1.0 / 120.0 + y2 * (-1.0 / 5040.0 + y2 * (1.0 / 362880.0 + y2 * (-1.0 / 39916800.0 + y2 * (1.0 / 6227020800.0 + y2 * (-1.0 / 1307674368000.0))))))));
    const double cp = 1.0 + y2 * (-0.5 + y2 * (1.0 / 24.0 + y2 * (-1.0 / 720.0 + y2 * (1.0 / 40320.0 + y2 * (-1.0 / 3628800.0 + y2 * (1.0 / 479001600.0 + y2 * (-1.0 / 87178291200.0 + y2 * (1.0 / 20922789888000.0))))))));
    const int k = qi & 3;
    s = (k == 0) ? sp : (k == 1) ? cp : (k == 2) ? -sp : -cp;
    c = (k == 0) ? cp : (k == 1) ? -sp : (k == 2) ? -cp : sp;
}
__device__ __forceinline__ double inv_freq(int j) {
    const int a = j >> 3, b = j & 7;
    const double pa = (a == 0) ? 1.0 : (a == 1) ? 0.1 : (a == 2) ? 0.01 : 0.001;
    const double pb = (b == 0) ? 1.0 : (b == 1) ? 0.7498942093324559 : (b == 2) ? 0.5623413251903491 : (b == 3) ? 0.4216965034285822 : (b == 4) ? 0.31622776601683794
                    : (b == 5) ? 0.23713737056616552 : (b == 6) ? 0.1778279410038923 : 0.1333521432163324;
    return pa * pb;
}

struct Args { const float* in[16]; float* out; unsigned char* ws; };
typedef const __attribute__((address_space(4))) Args* KArgs;
__device__ __forceinline__ KArgs kargs() { auto p = __builtin_amdgcn_kernarg_segment_ptr(); asm volatile("" : "+s"(p)); return (KArgs)p; }
#define KA_IN(i) (kargs()->in[i])
#define KA_WS() (kargs()->ws)
#define KA_OUT() (kargs()->out)
__global__ void __launch_bounds__(NWAVES * 64, 2) fwd(Args args) {
    (void)args;
    extern __shared__ __attribute__((aligned(16))) unsigned char lds[];
    LAS unsigned char* const ldsl = (LAS unsigned char*)lds;
    const int wave0 = __builtin_amdgcn_readfirstlane(threadIdx.x >> 6);
    constexpr int G = NBLK; const int bx = blockIdx.x, vcu = (bx % 8) * (G / 8) + bx / 8;
    constexpr int NGW = G * NWAVES, NGT = G * NWAVES * 64;
#define IDS() int wave_ = wave0; asm volatile("" : "+s"(wave_)); const int lane = fresh_lane(), wave = wave_, tid = wave * 64 + lane; const int gw = vcu * NWAVES + wave, gt = vcu * (NWAVES * 64) + tid; (void)lane; (void)gw; (void)gt; (void)tid
    { IDS(); for (int u = tid; u < (LDS_BYTES - LDSCTL_OFF) / 4; u += NWAVES * 64) ((LAS unsigned*)(ldsl + LDSCTL_OFF))[u] = 0u; }
    __syncthreads();
    XcdBarrier bar0 = xcd_barrier_post((unsigned*)(KA_WS() + WS_CTL) + CW_BAR, (volatile LAS unsigned*)(ldsl + MISC_OFF) + 8);
    const unsigned bar_x = bar0.x;
#define GRID_BAR() do { XcdBarrier b_; b_.bar = (unsigned*)(KA_WS() + WS_CTL) + CW_BAR; b_.x = bar_x; b_.st = (volatile LAS unsigned*)(ldsl + MISC_OFF) + 8; b_.leader = (wave0 == 0) && (fresh_lane() == 0); xcd_barrier(b_); } while (0)
#define SCR() ((LAS float*)(ldsl + RING_OFF + wave * 16384))

    { IDS(); unsigned char* const ws = KA_WS(); float* const tabc = (float*)(ws + WS_ROPE_C); float* const tabs = (float*)(ws + WS_ROPE_S);
      for (int e = gt; e < SEQ_P * 32; e += NGT) { const int pos = e >> 5, j = e & 31; double s, c; sincos_d((double)pos * inv_freq(j), s, c); tabc[e] = (float)c; tabs[e] = (float)s; } }

    for (int layer = 0; layer < 4; ++layer) {
        const int lj = layer >> 1; const bool isB = (layer & 1) != 0;
        for (int rep = 0; rep < REP_THIN; ++rep)
        {
            constexpr int I_G = (DM / 64) * (DFF / 32), I_D = (DFF / 64) * (DM / 32), I_O = (DM / 64) * (DM / 32);
            if (!isB) {
                constexpr int I_QKV = (DM / 64) * (NQKV / 32);
                { IDS(); unsigned char* const ws = KA_WS(); const float* wqkv = KA_IN(5) + (size_t)lj * DM * NQKV;
                  for (int it = gw; it < I_QKV; it += NGW) tr_item<0>(wqkv, NQKV, (bf16_t*)(ws + W_QKV), DM, SCR(), it, lane); }
                { IDS(); unsigned char* const ws = KA_WS(); const float* wo = KA_IN(6) + (size_t)lj * DM * DM;
                  for (int it = gw; it < I_O; it += NGW) tr_item<0>(wo, DM, (bf16_t*)(ws + W_O), DM, SCR(), it, lane); }
            } else {
                constexpr int I_A = (DM / 64) * (NA / 32), I_UQ = (QLR / 64) * (NQ / 32), I_UKV = (KVL / 64) * (NKV / 32);
                { IDS(); unsigned char* const ws = KA_WS(); const float* wa = KA_IN(7) + (size_t)lj * DM * NA;
                  for (int it = gw; it < I_A; it += NGW) tr_item<0>(wa, NA, (bf16_t*)(ws + W_WA), DM, SCR(), it, lane); }
                { IDS(); unsigned char* const ws = KA_WS(); const float* wuq = KA_IN(10) + (size_t)lj * QLR * NQ;
                  for (int it = gw; it < I_UQ; it += NGW) tr_item<3>(wuq, NQ, (bf16_t*)(ws + W_UQ), QLP, SCR(), it, lane);
                  for (int e = gt; e < NQ * 8; e += NGT) *(GAS u32x4*)((bf16_t*)(ws + W_UQ) + (size_t)(e >> 3) * QLP + QLR + (e & 7) * 8) = (u32x4){0u, 0u, 0u, 0u}; }
                { IDS(); unsigned char* const ws = KA_WS(); const float* wukv = KA_IN(11) + (size_t)lj * KVL * NKV;
                  for (int it = gw; it < I_UKV; it += NGW) tr_item<0>(wukv, NKV, (bf16_t*)(ws + W_UKV), KVL, SCR(), it, lane); }
                { IDS(); unsigned char* const ws = KA_WS(); const float* wo = KA_IN(12) + (size_t)lj * DM * DM;
                  for (int it = gw; it < I_O; it += NGW) tr_item<0>(wo, DM, (bf16_t*)(ws + W_O), DM, SCR(), it, lane); }
            }
            { IDS(); unsigned char* const ws = KA_WS(); const float* wg = KA_IN(13) + (size_t)layer * DM * DFF;
              for (int it = gw; it < I_G; it += NGW) tr_item<1>(wg, DFF, (bf16_t*)(ws + W_GU), DM, SCR(), it, lane); }
            { IDS(); unsigned char* const ws = KA_WS(); const float* wu = KA_IN(14) + (size_t)layer * DM * DFF;
              for (int it = gw; it < I_G; it += NGW) tr_item<2>(wu, DFF, (bf16_t*)(ws + W_GU), DM, SCR(), it, lane); }
            { IDS(); unsigned char* const ws = KA_WS(); const float* wd = KA_IN(15) + (size_t)layer * DFF * DM;
              for (int it = gw; it < I_D; it += NGW) tr_item<0>(wd, DM, (bf16_t*)(ws + W_DN), DFF, SCR(), it, lane); }
            if (layer == 0) { IDS(); unsigned char* const ws = KA_WS(); bf16_t* const Hb = (bf16_t*)(ws + WS_H); float* const X = KA_OUT(); const float* norm_mix = KA_IN(2); pg8::u64* const ss0 = (pg8::u64*)(ws + WS_SS);
              f32x4 gn[8];
#pragma unroll
              for (int j = 0; j < 8; ++j) gn[j] = *(const f32x4*)(norm_mix + 4 * lane + 256 * j);
              const float* x_prompt = KA_IN(0); const float* x_sample = KA_IN(1);
              for (int m = gw; m < T_ALL; m += NGW) { const float* src = m < T_PROMPT ? x_prompt + (size_t)m * DM : x_sample + (size_t)(m - T_PROMPT) * DM; prep_row0(src, gn, Hb + (size_t)m * DM, X + (size_t)m * DM, ss0 + m, lane); } }
        }
        GRID_BAR();
        if (!isB) {
            for (int ch = 0; ch < NCHUNK; ++ch) {
                for (int rep = 0; rep < REP_QKV; ++rep)
                { IDS(); unsigned char* const ws = KA_WS();
                  pg8::Gemm g{(const bf16_t*)(ws + WS_H) + (size_t)ch * CHUNK * DM, (const bf16_t*)(ws + W_QKV), CHUNK, NQKV, DM}; pg8::StaticOrder S; S.init(CHUNK, NQKV, G, bx);
                  pg8::EpiBf16 E{(bf16_t*)(ws + S_QKV), NQKV, CHUNK, (const pg8::u64*)(ws + WS_SS) + (size_t)(2 * layer) * T_ALL + (size_t)ch * CHUNK}; pg8::gemm_phase<pg8::EpiBf16, pg8::StaticOrder>(ldsl + RING_OFF, g, S, E, wave0); }
                GRID_BAR();
                { IDS(); unsigned char* const ws = KA_WS(); const bf16_t* const QKV = (const bf16_t*)(ws + S_QKV); bf16_t* const OG = (bf16_t*)(ws + S_OG); float* const LSE = (float*)(ws + S_LSE);
                  const int S_len = ch < 4 ? SEQ_P : SEQ_S, nseq = ch < 4 ? 1 : 2, RN = S_len / 256, per_seq = 3 * NH * RN, nitems = nseq * per_seq;
                  for (int rep = 0; rep < REP_DWA; ++rep)
                  for (int it = vcu; it < nitems; it += G) {
                      const int sq = it / per_seq, r0 = it % per_seq, g = r0 / (NH * RN), r1 = r0 % (NH * RN), h = r1 / RN, rn = r1 % RN;
                      const int dil = g == 0 ? 1 : (g == 1 ? 4 : 16), nb4 = RN / dil;
                      const int res = rn / nb4, n4 = rn % nb4;
                      dwa::item(QKV, OG, LSE, sq * S_len, S_len, g, dil, res, n4 * 4, h, (char*)lds + RING_OFF, wave0); } }
                GRID_BAR();
                for (int rep = 0; rep < REP_THIN; ++rep)
                { IDS(); unsigned char* const ws = KA_WS(); const bf16_t* const OG = (const bf16_t*)(ws + S_OG); const float* const LSE = (const float*)(ws + S_LSE); bf16_t* const OA = (bf16_t*)(ws + S_OA);
                  for (int e = gt; e < CHUNK * (DM / 8); e += NGT) { const int row = e >> 8, c8 = e & 255, h = c8 >> 4;
                    const float l0 = LSE[(row * 3 + 0) * NH + h], l1 = LSE[(row * 3 + 1) * NH + h], l2 = LSE[(row * 3 + 2) * NH + h];
                    const float mx = fmaxf(l0, fmaxf(l1, l2)); float w0 = __builtin_amdgcn_exp2f(l0 - mx), w1 = __builtin_amdgcn_exp2f(l1 - mx), w2 = __builtin_amdgcn_exp2f(l2 - mx);
                    const float inv = 1.f / (w0 + w1 + w2); w0 *= inv; w1 *= inv; w2 *= inv;
                    const u32x4 a0 = *(const u32x4*)(OG + ((size_t)row * 3 + 0) * DM + c8 * 8), a1 = *(const u32x4*)(OG + ((size_t)row * 3 + 1) * DM + c8 * 8), a2 = *(const u32x4*)(OG + ((size_t)row * 3 + 2) * DM + c8 * 8);
                    u32x4 o;
#pragma unroll
                    for (int k = 0; k < 4; ++k) { const float lo = w0 * __uint_as_float(a0[k] << 16) + w1 * __uint_as_float(a1[k] << 16) + w2 * __uint_as_float(a2[k] << 16);
                        const float hi = w0 * __uint_as_float(a0[k] & 0xffff0000u) + w1 * __uint_as_float(a1[k] & 0xffff0000u) + w2 * __uint_as_float(a2[k] & 0xffff0000u); o[k] = cvt_pk_bf16(lo, hi); }
                    *(u32x4*)(OA + ((size_t)ch * CHUNK + row) * DM + c8 * 8) = o; } }
            }
        } else {
            { IDS(); unsigned char* const ws = KA_WS();
              pg8::Gemm g{(const bf16_t*)(ws + WS_H), (const bf16_t*)(ws + W_WA), T_ALL, NA, DM}; pg8::StaticOrder S; S.init(T_ALL, NA, G, bx);
              pg8::EpiF32 E{(float*)(ws + S_A), NA, (const pg8::u64*)(ws + WS_SS) + (size_t)(2 * layer) * T_ALL}; pg8::gemm_phase<pg8::EpiF32, pg8::StaticOrder>(ldsl + RING_OFF, g, S, E, wave0); }
            GRID_BAR();
            for (int rep = 0; rep < REP_THIN; ++rep)
            {
                IDS(); unsigned char* const ws = KA_WS(); const float* const Af = (const float*)(ws + S_A); bf16_t* const CQ = (bf16_t*)(ws + S_CQ); bf16_t* const CKV = (bf16_t*)(ws + S_CKV); bf16_t* const KR = (bf16_t*)(ws + S_KR);
                const float* const tabc = (const float*)(ws + WS_ROPE_C); const float* const tabs = (const float*)(ws + WS_ROPE_S);
                const float* gq = KA_IN(8) + lj * QLR; const float* gkv = KA_IN(9) + lj * KVL;
                f32x4 gs[4];
#pragma unroll
                for (int j = 0; j < 4; ++j) gs[j] = lane < 28 ? *(const f32x4*)(gq + 16 * lane + 4 * j) : (lane < 60 ? *(const f32x4*)(gkv + 16 * (lane - 28) + 4 * j) : (f32x4){1.f, 1.f, 1.f, 1.f});
                for (int m = gw; m < T_ALL; m += NGW) {
                    f32x4 v[4]; float ss = 0.f;
#pragma unroll
                    for (int j = 0; j < 4; ++j) { v[j] = *(const f32x4*)(Af + (size_t)m * NA + 16 * lane + 4 * j); ss += (v[j].x * v[j].x + v[j].y * v[j].y) + (v[j].z * v[j].z + v[j].w * v[j].w); }
                    const float sq = wave_sum(lane < 28 ? ss : 0.f, lane), skv = wave_sum((lane >= 28 && lane < 60) ? ss : 0.f, lane);
                    const float rq = 1.f / sqrtf(sq * (1.f / QLR) + NORM_EPS), rkv = 1.f / sqrtf(skv * (1.f / KVL) + NORM_EPS);
                    f32x4 pv_[4];
#pragma unroll
                    for (int j = 0; j < 4; ++j) { pv_[j].x = shfl_xor_f(v[j].x, 2, lane); pv_[j].y = shfl_xor_f(v[j].y, 2, lane); pv_[j].z = shfl_xor_f(v[j].z, 2, lane); pv_[j].w = shfl_xor_f(v[j].w, 2, lane); }
                    if (lane < 32) { u32x4 w0 = {0u, 0u, 0u, 0u}, w1 = {0u, 0u, 0u, 0u};
                        if (lane < 28) { const f32x4 y0 = (v[0] * rq) * gs[0], y1 = (v[1] * rq) * gs[1], y2 = (v[2] * rq) * gs[2], y3 = (v[3] * rq) * gs[3];
                            w0 = (u32x4){cvt_pk_bf16(y0.x, y0.y), cvt_pk_bf16(y0.z, y0.w), cvt_pk_bf16(y1.x, y1.y), cvt_pk_bf16(y1.z, y1.w)};
                            w1 = (u32x4){cvt_pk_bf16(y2.x, y2.y), cvt_pk_bf16(y2.z, y2.w), cvt_pk_bf16(y3.x, y3.y), cvt_pk_bf16(y3.z, y3.w)}; }
                        *(u32x4*)(CQ + (size_t)m * QLP + 16 * lane) = w0; *(u32x4*)(CQ + (size_t)m * QLP + 16 * lane + 8) = w1; }
                    if (lane >= 28 && lane < 60) { const f32x4 y0 = (v[0] * rkv) * gs[0], y1 = (v[1] * rkv) * gs[1], y2 = (v[2] * rkv) * gs[2], y3 = (v[3] * rkv) * gs[3];
                        const u32x4 w0 = {cvt_pk_bf16(y0.x, y0.y), cvt_pk_bf16(y0.z, y0.w), cvt_pk_bf16(y1.x, y1.y), cvt_pk_bf16(y1.z, y1.w)};
                        const u32x4 w1 = {cvt_pk_bf16(y2.x, y2.y), cvt_pk_bf16(y2.z, y2.w), cvt_pk_bf16(y3.x, y3.y), cvt_pk_bf16(y3.z, y3.w)};
                        *(u32x4*)(CKV + (size_t)m * KVL + 16 * (lane - 28)) = w0; *(u32x4*)(CKV + (size_t)m * KVL + 16 * (lane - 28) + 8) = w1; }
                    if (lane >= 60) { const int pos = row_pos(m), jb = 16 * (lane & 1); const bool is_t2 = lane >= 62;
#pragma unroll
                        for (int q = 0; q < 4; ++q) { const f32x4 c = *(const f32x4*)(tabc + pos * 32 + jb + 4 * q), s = *(const f32x4*)(tabs + pos * 32 + jb + 4 * q);
                            const f32x4 t1 = is_t2 ? pv_[q] : v[q], t2 = is_t2 ? v[q] : pv_[q];
                            const f32x4 o = is_t2 ? (t1 * s + t2 * c) : (t1 * c - t2 * s);
                            u32x2 w; w.x = cvt_pk_bf16(o.x, o.y); w.y = cvt_pk_bf16(o.z, o.w);
                            *(u32x2*)(KR + (size_t)m * 64 + 8 * (4 * (lane & 1) + q) + (is_t2 ? 4 : 0)) = w; } }
                }
            }
            GRID_BAR();
            { IDS(); unsigned char* const ws = KA_WS();
              pg8::Gemm g{(const bf16_t*)(ws + S_CQ), (const bf16_t*)(ws + W_UQ), T_ALL, NQ, QLP}; pg8::StaticOrder S; S.init(T_ALL, NQ, G, bx);
              pg8::EpiQRope E{(bf16_t*)(ws + S_Q), NQ, (const float*)(ws + WS_ROPE_C), (const float*)(ws + WS_ROPE_S), 0}; pg8::gemm_phase<pg8::EpiQRope, pg8::StaticOrder>(ldsl + RING_OFF, g, S, E, wave0); }
            { IDS(); unsigned char* const ws = KA_WS();
              pg8::Gemm g{(const bf16_t*)(ws + S_CKV), (const bf16_t*)(ws + W_UKV), T_ALL, NKV, KVL}; pg8::StaticOrder S; S.init(T_ALL, NKV, G, bx);
              pg8::EpiBf16 E{(bf16_t*)(ws + S_KV), NKV, 0, nullptr}; pg8::gemm_phase<pg8::EpiBf16, pg8::StaticOrder>(ldsl + RING_OFF, g, S, E, wave0); }
            GRID_BAR();
            {
                IDS(); unsigned char* const ws = KA_WS(); const bf16_t* const Qb = (const bf16_t*)(ws + S_Q); const bf16_t* const KVb = (const bf16_t*)(ws + S_KV); const bf16_t* const KR = (const bf16_t*)(ws + S_KR); bf16_t* const Ob = (bf16_t*)(ws + S_OB);
                for (int rep = 0; rep < REP_MLA; ++rep)
                for (int id = vcu; id < 2560; id += G) {
                    int seqrow0, seqlen, h, qb;
                    if (id < 2048) { const int pair = id >> 5; qb = id & 31; h = pair & 15; seqrow0 = (pair >> 4) * SEQ_P; seqlen = SEQ_P; }
                    else { const int i2 = id - 2048, pair = i2 >> 4; qb = i2 & 15; h = pair & 15; seqrow0 = T_PROMPT + (pair >> 4) * SEQ_S; seqlen = SEQ_S; }
                    mla::attn_unit(Qb + (size_t)(seqrow0 + qb * 256) * NQ + h * 192, KVb + (size_t)seqrow0 * NKV + h * 256, KR + (size_t)seqrow0 * 64, KVb + (size_t)seqrow0 * NKV + h * 256 + 128,
                                   Ob + (size_t)(seqrow0 + qb * 256) * DM + h * 128, seqlen, (char*)lds + RING_OFF, wave0); }
            }
        }
        GRID_BAR();
        { IDS(); unsigned char* const ws = KA_WS();
          pg8::Gemm g{(const bf16_t*)(ws + (isB ? S_OB : S_OA)), (const bf16_t*)(ws + W_O), T_ALL, DM, DM}; pg8::StaticOrder S; S.init(T_ALL, DM, G, bx);
          pg8::EpiRes E{KA_OUT(), DM, (bf16_t*)(ws + WS_H), KA_IN(3) + layer * DM, (pg8::u64*)(ws + WS_SS) + (size_t)(2 * layer + 1) * T_ALL};
          pg8::gemm_phase<pg8::EpiRes, pg8::StaticOrder>(ldsl + RING_OFF, g, S, E, wave0); }
        GRID_BAR();
        for (int rep = 0; rep < REP_FFN; ++rep)
        { IDS(); unsigned char* const ws = KA_WS();
          pg8::Gemm g{(const bf16_t*)(ws + WS_H), (const bf16_t*)(ws + W_GU), T_ALL, 2 * DFF, DM}; pg8::StaticOrder S; S.init(T_ALL, 2 * DFF, G, bx);
          pg8::EpiSwiGLU E{(bf16_t*)(ws + S_ACT), DFF, (const pg8::u64*)(ws + WS_SS) + (size_t)(2 * layer + 1) * T_ALL}; pg8::gemm_phase<pg8::EpiSwiGLU, pg8::StaticOrder>(ldsl + RING_OFF, g, S, E, wave0); }
        GRID_BAR();
        { IDS(); unsigned char* const ws = KA_WS();
          pg8::Gemm g{(const bf16_t*)(ws + S_ACT), (const bf16_t*)(ws + W_DN), T_ALL, DM, DFF}; pg8::StaticOrder S; S.init(T_ALL, DM, G, bx);
          pg8::EpiRes E{KA_OUT(), DM, layer < 3 ? (bf16_t*)(ws + WS_H) : nullptr, KA_IN(2) + (layer < 3 ? layer + 1 : 0) * DM, (pg8::u64*)(ws + WS_SS) + (size_t)(2 * layer + 2) * T_ALL};
          pg8::gemm_phase<pg8::EpiRes, pg8::StaticOrder>(ldsl + RING_OFF, g, S, E, wave0); }
        GRID_BAR();
    }
    { IDS(); float* const X = KA_OUT(); const float* norm_final = KA_IN(4);
      f32x4 gn[8];
#pragma unroll
      for (int j = 0; j < 8; ++j) gn[j] = *(const f32x4*)(norm_final + 4 * lane + 256 * j);
      const unsigned dead = __hip_atomic_load((unsigned*)(KA_WS() + WS_CTL) + CW_BAR + XB_TMO, RLX_AGENT);
      for (int m = gw; m < T_ALL; m += NGW) { rms_row_f32(X + (size_t)m * DM, gn, lane);
          if (dead) { const float qn = __builtin_nanf(""); ((GAS f32x4*)(X + (size_t)m * DM))[lane] = (f32x4){qn, qn, qn, qn}; } } }
}

extern "C" void kernel_launch(void* const* d_in, const int* in_sizes, int n_in, void* d_out, int out_size, void* d_ws, size_t ws_size, hipStream_t stream) {
    static int grid = 0;
    if (grid == 0) {
        if (n_in != 16 || out_size != T_ALL * DM || ws_size < WS_END) { fprintf(stderr, "kernel_launch: shape mismatch (n_in %d out %d ws %zu, need ws >= %zu)\n", n_in, out_size, ws_size, (size_t)WS_END); grid = -1; return; }
        int dev = 0, cus = 0, per_cu = 0;
        if (hipGetDevice(&dev) != hipSuccess || hipDeviceGetAttribute(&cus, hipDeviceAttributeMultiprocessorCount, dev) != hipSuccess) { grid = -1; return; }
        if (hipFuncSetAttribute((const void*)fwd, hipFuncAttributeMaxDynamicSharedMemorySize, LDS_BYTES) != hipSuccess) { fprintf(stderr, "kernel_launch: hipFuncSetAttribute failed\n"); grid = -1; return; }
        if (hipOccupancyMaxActiveBlocksPerMultiprocessor(&per_cu, (const void*)fwd, NWAVES * 64, LDS_BYTES) != hipSuccess || per_cu < 1)
            fprintf(stderr, "kernel_launch: occupancy query reports %d workgroups per CU\n", per_cu);
        (void)hipGetLastError();
        if (cus < NBLK) { fprintf(stderr, "kernel_launch: built for %d CUs, device has %d\n", NBLK, cus); grid = -1; return; }
        grid = NBLK;
    }
    if (grid < 0) return;
    if (hipMemsetAsync((char*)d_ws + WS_CTL, 0, CTL_ZERO_BYTES, stream) != hipSuccess) { fprintf(stderr, "kernel_launch: memset failed\n"); return; }
    Args a{};
    for (int i = 0; i < 16; ++i) a.in[i] = (const float*)d_in[i];
    a.out = (float*)d_out; a.ws = (unsigned char*)d_ws;
    hipLaunchKernelGGL(fwd, dim3(grid), dim3(NWAVES * 64), LDS_BYTES, stream, a);
    const hipError_t le = hipPeekAtLastError();
    if (le != hipSuccess) fprintf(stderr, "kernel_launch: launch failed: %s\n", hipGetErrorName(le));
}
```

```cpp
#include <hip/hip_runtime.h>
#include <cstdio>
#include <cstdint>
#ifndef PROBE_CLASS
#define PROBE_CLASS 0
#endif
#define PROBE_AMP 8
#ifndef PROBE_MODE
#define PROBE_MODE 0
#endif
enum { PC_NONE = 0, PC_PREP = 1, PC_QKV = 2, PC_DWA = 3, PC_MERGE = 4, PC_WA = 5, PC_ANORM = 6, PC_QKVB = 7, PC_MLA = 8, PC_WO = 9, PC_GU = 10, PC_DOWN = 11 };
#ifndef REP_FFN
#define REP_FFN 1
#endif
#ifndef REP_MLA
#define REP_MLA 1
#endif
#ifndef REP_THIN
#define REP_THIN 1
#endif
#ifndef REP_DWA
#define REP_DWA 1
#endif
#ifndef REP_QKV
#define REP_QKV 1
#endif

#define LAS __attribute__((address_space(3)))
#define GAS __attribute__((address_space(1)))
typedef unsigned short bf16_t;
typedef short bf16x8 __attribute__((ext_vector_type(8)));
typedef short s16x4 __attribute__((ext_vector_type(4)));
typedef float f32x4 __attribute__((ext_vector_type(4)));
typedef float f32x2 __attribute__((ext_vector_type(2)));
typedef float f32x16 __attribute__((ext_vector_type(16)));
typedef unsigned u32x4 __attribute__((ext_vector_type(4)));
typedef unsigned u32x2 __attribute__((ext_vector_type(2)));
typedef GAS unsigned gu32;

constexpr int DM = 2048, T_ALL = 40960, T_PROMPT = 32768, SEQ_P = 8192, SEQ_S = 4096;
constexpr int DFF = 5632, NQKV = 18432, NA = 1024, QLR = 448, QLP = 512, KVL = 512, NQ = 3072, NKV = 4096, NH = 16;
constexpr int CHUNK = 8192, NCHUNK = 5;
constexpr float NORM_EPS = 1e-6f;
constexpr float LOG2E = 1.4426950408889634f;

__device__ __forceinline__ int fresh_lane() { int l; asm volatile("v_mbcnt_lo_u32_b32 %0, -1, 0\n\tv_mbcnt_hi_u32_b32 %0, -1, %0" : "=v"(l)); return l; }
__device__ __forceinline__ unsigned cvt_pk_bf16(float lo, float hi) { unsigned r; asm volatile("v_cvt_pk_bf16_f32 %0, %1, %2" : "=v"(r) : "v"(lo), "v"(hi)); return r; }
__device__ __forceinline__ int row_pos(int row) { return row < T_PROMPT ? (row & (SEQ_P - 1)) : (row & (SEQ_S - 1)); }

namespace pg8 {
constexpr int BM = 256, BK = 64, HALF = 128, HTB = HALF * BK * 2, STAGE_BYTES = 8 * HTB, NXCD = 8, WGM = 8;
__host__ __device__ __forceinline__ int lds_byte(int r, int c) { const int st = (r >> 4) * 2 + (c >> 5), rr = r & 15, cc = c & 31, ob = rr * 64 + cc * 2; return st * 1024 + (ob ^ (((ob >> 9) & 1) << 5)); }
__host__ __device__ __forceinline__ void stage_rc(int b, int& R, int& C) { const int st = b / 1024, sb = b % 1024, swz = sb ^ (((sb >> 9) & 1) << 5); R = (st >> 1) * 16 + swz / 64; C = (st & 1) * 32 + (swz % 64) / 2; }
__host__ __device__ __forceinline__ int perm32(int rho) { const int n = rho >> 4, i = rho & 15; return 8 * (i >> 2) + 4 * n + (i & 3); }

struct Unit { int pm, pn; };
struct Gemm { const bf16_t* A; const bf16_t* Bt; int M, N, K; };

struct StaticOrder {
    int nM, nN, nwg, G, c;
    __host__ __device__ void init(int M, int N, int G_, int c_) { nM = M / BM; nN = N / BM; nwg = nM * nN; G = G_; c = c_; }
    __host__ __device__ bool next(int i, Unit& u) const {
        const long L = (long)i * G + c; if (L >= nwg) return false;
        int wgid = (int)L; { const int q = nwg / NXCD, r = nwg % NXCD, xcd = wgid % NXCD, off = wgid / NXCD; wgid = (xcd < r ? xcd * (q + 1) : r * (q + 1) + (xcd - r) * q) + off; }
        const int nig = WGM * nN, gid = wgid / nig, fm = gid * WGM, gsz = (nM - fm) < WGM ? (nM - fm) : WGM;
        u.pm = fm + ((wgid % nig) % gsz); u.pn = (wgid % nig) / gsz; return true;
    }
    __device__ __forceinline__ void a_ready(const Unit&) const {}
    __device__ __forceinline__ void done(const Unit&) const {}
};

typedef unsigned long long u64;
constexpr float SS_SCALE = 1048576.0f, SS_INV = 1.0f / 1048576.0f;
__device__ __forceinline__ float u64_to_f32(unsigned lo, unsigned hi) { return fmaf((float)hi, 4294967296.0f, (float)lo); }
__device__ __forceinline__ u64 f32_to_u64(float qs) {
    const unsigned hi = (unsigned)(qs * (1.0f / 4294967296.0f)); const unsigned lo = (unsigned)fmaf(-(float)hi, 4294967296.0f, qs); return ((u64)hi << 32) | lo; }
__device__ __forceinline__ float row_rstd(const u64* ss, int row) { return ss ? __builtin_amdgcn_rsqf((float)ss[row] * (SS_INV / DM) + NORM_EPS) : 1.0f; }
struct PreNone { };
struct PreSS { int off; };
constexpr int SS_LDS = STAGE_BYTES;
__device__ __forceinline__ void prefetch_ss(PreSS& p, const u64* ss, const Unit& u, LAS unsigned char* lds, int ui, int wid, int lane) {
    p.off = SS_LDS + (ui & 1) * 2048;
    if (ss && wid == 0) {
        const u64* src = ss + (size_t)u.pm * BM + lane * 2;
        __builtin_amdgcn_global_load_lds((const unsigned*)src, (LAS unsigned*)(lds + p.off), 16, 0, 0);
        __builtin_amdgcn_global_load_lds((const unsigned*)(src + 128), (LAS unsigned*)(lds + p.off + 1024), 16, 0, 0); }
}
__device__ __forceinline__ float pre_rstd(const PreSS& p, const u64* ss, LAS unsigned char* lds, int rowt, float inv_n = 1.0f / DM) { if (!ss) return 1.0f; const u32x2 w = *(const LAS u32x2*)(lds + p.off + rowt * 8); return __builtin_amdgcn_rsqf(u64_to_f32(w.x, w.y) * (SS_INV * inv_n) + NORM_EPS); }
struct EpiBf16 {
    static constexpr bool PERM = true, AFTER_DRAIN = false; static constexpr bool PEEL = true; static constexpr int NST = 16;
    bf16_t* O; int ldc; int sect_rows; const u64* ss; float inv_n = 1.0f / DM;
    typedef PreSS Pre;
    __device__ __forceinline__ void prefetch(Pre& p, const Unit& u, LAS unsigned char* lds, int ui, int wid, int lane) const { prefetch_ss(p, ss, u, lds, ui, wid, lane); }
    __device__ __forceinline__ void operator()(const f32x4 (&acc)[2][2][4][2], const Unit& u, int wr, int wc, int fr, int fq, const Pre& pre, LAS unsigned char* lds) const {
        const int row0 = u.pm * BM + wr * 64 + fr, col0 = u.pn * BM + wc * 32 + 8 * fq;
#pragma unroll
        for (int ai = 0; ai < 2; ++ai)
#pragma unroll
            for (int m = 0; m < 4; ++m) { const int row = row0 + ai * HALF + m * 16; const float rs = pre_rstd(pre, ss, lds, ai * HALF + wr * 64 + m * 16 + fr, inv_n);
#pragma unroll
                for (int bj = 0; bj < 2; ++bj) { const f32x4 v0 = acc[ai][bj][m][0] * rs, v1 = acc[ai][bj][m][1] * rs;
                    bf16_t* p = sect_rows ? O + ((size_t)(2 * u.pn + bj) * sect_rows + row) * 128 + wc * 32 + 8 * fq : O + (size_t)row * ldc + col0 + bj * HALF;
                    u32x4 w; w.x = cvt_pk_bf16(v0[0], v0[1]); w.y = cvt_pk_bf16(v0[2], v0[3]); w.z = cvt_pk_bf16(v1[0], v1[1]); w.w = cvt_pk_bf16(v1[2], v1[3]);
                    *(u32x4*)p = w; } }
    }
};
struct EpiQRope {
    static constexpr bool PERM = true, AFTER_DRAIN = false; static constexpr bool PEEL = true; static constexpr int NST = 16;
    bf16_t* O; int ldc; const float* tabc; const float* tabs; int row_base; const u64* ss; float inv_n;
    typedef PreSS Pre;
    __device__ __forceinline__ void prefetch(Pre& p, const Unit& u, LAS unsigned char* lds, int ui, int wid, int lane) const { prefetch_ss(p, ss, u, lds, ui, wid, lane); }
    __device__ __forceinline__ void operator()(const f32x4 (&acc)[2][2][4][2], const Unit& u, int wr, int wc, int fr, int fq, const Pre& pre, LAS unsigned char* lds) const {
        const int row0 = u.pm * BM + wr * 64 + fr, col0 = u.pn * BM + wc * 32 + 8 * fq;
#pragma unroll
        for (int bj = 0; bj < 2; ++bj) {
            const int G = u.pn * 8 + bj * 4 + wc, within = G % 6;
            const bool rope = within >= 4; const int j0 = 16 * (within - 4) + 4 * fq;
#pragma unroll
            for (int ai = 0; ai < 2; ++ai)
#pragma unroll
                for (int m = 0; m < 4; ++m) { const int row = row0 + ai * HALF + m * 16; bf16_t* rowp = O + (size_t)row * ldc + col0 + bj * HALF;
                    const float rs = pre_rstd(pre, ss, lds, ai * HALF + wr * 64 + m * 16 + fr, inv_n);
                    f32x4 v0 = acc[ai][bj][m][0] * rs, v1 = acc[ai][bj][m][1] * rs;
                    if (rope) { const int pos = row_pos(row_base + row); const f32x4 c = *(const f32x4*)(tabc + pos * 32 + j0), s = *(const f32x4*)(tabs + pos * 32 + j0);
                        const f32x4 o1 = v0 * c - v1 * s, o2 = v0 * s + v1 * c; v0 = o1; v1 = o2; }
                    u32x4 w; w.x = cvt_pk_bf16(v0[0], v0[1]); w.y = cvt_pk_bf16(v0[2], v0[3]); w.z = cvt_pk_bf16(v1[0], v1[1]); w.w = cvt_pk_bf16(v1[2], v1[3]);
                    *(u32x4*)rowp = w; }
        }
    }
};
struct EpiSwiGLU {
    static constexpr bool PERM = true, AFTER_DRAIN = false; static constexpr bool PEEL = true; static constexpr int NST = 8;
    bf16_t* O; int ldc; const u64* ss;
    typedef PreSS Pre;
    __device__ __forceinline__ void prefetch(Pre& p, const Unit& u, LAS unsigned char* lds, int ui, int wid, int lane) const { prefetch_ss(p, ss, u, lds, ui, wid, lane); }
    __device__ __forceinline__ void operator()(const f32x4 (&acc)[2][2][4][2], const Unit& u, int wr, int wc, int fr, int fq, const Pre& pre, LAS unsigned char* lds) const {
        const int row0 = u.pm * BM + wr * 64 + fr, col0 = u.pn * HALF + wc * 32 + 8 * fq;
#pragma unroll
        for (int ai = 0; ai < 2; ++ai)
#pragma unroll
            for (int m = 0; m < 4; ++m) { const int row = row0 + ai * HALF + m * 16; bf16_t* rowp = O + (size_t)row * ldc + col0; const float rs = pre_rstd(pre, ss, lds, ai * HALF + wr * 64 + m * 16 + fr);
                const float rsl = -rs * LOG2E, rs2 = rs * rs; f32x4 o4[2];
#pragma unroll
                for (int n = 0; n < 2; ++n) { const f32x4 G = acc[ai][0][m][n], U = acc[ai][1][m][n]; const f32x4 T = G * rsl;
                    f32x4 D = (f32x4){__builtin_amdgcn_exp2f(T[0]), __builtin_amdgcn_exp2f(T[1]), __builtin_amdgcn_exp2f(T[2]), __builtin_amdgcn_exp2f(T[3])} + 1.0f;
                    const f32x4 R = (f32x4){__builtin_amdgcn_rcpf(D[0]), __builtin_amdgcn_rcpf(D[1]), __builtin_amdgcn_rcpf(D[2]), __builtin_amdgcn_rcpf(D[3])};
                    o4[n] = (G * U) * (R * rs2); }
                u32x4 w; w.x = cvt_pk_bf16(o4[0][0], o4[0][1]); w.y = cvt_pk_bf16(o4[0][2], o4[0][3]); w.z = cvt_pk_bf16(o4[1][0], o4[1][1]); w.w = cvt_pk_bf16(o4[1][2], o4[1][3]);
                *(u32x4*)rowp = w; }
    }
};
struct EpiRes {
    static constexpr bool PERM = true, AFTER_DRAIN = false; static constexpr bool PEEL = true; static constexpr int NST = 16;
    bf16_t* x; int ldc; u64* ss;
    typedef PreNone Pre;
    __device__ __forceinline__ void prefetch(Pre&, const Unit&, LAS unsigned char*, int, int, int) const {}
    __device__ __forceinline__ void operator()(const f32x4 (&acc)[2][2][4][2], const Unit& u, int wr, int wc, int fr, int fq, const Pre&, LAS unsigned char*) const {
        const int col0 = u.pn * BM + wc * 32 + 8 * fq, lane = fq * 16 + fr;
        u32x4 b[2][4][2];
#pragma unroll
        for (int ai = 0; ai < 2; ++ai)
#pragma unroll
            for (int m = 0; m < 4; ++m) { const bf16_t* rowp = x + (size_t)(u.pm * BM + ai * HALF + wr * 64 + m * 16 + fr) * ldc + col0;
#pragma unroll
                for (int bj = 0; bj < 2; ++bj) b[ai][m][bj] = *(const u32x4*)(rowp + bj * HALF); }
        asm volatile("" ::: "memory");
#pragma unroll
        for (int ai = 0; ai < 2; ++ai)
#pragma unroll
            for (int m = 0; m < 4; ++m) { const int row = u.pm * BM + ai * HALF + wr * 64 + m * 16 + fr; bf16_t* rowp = x + (size_t)row * ldc + col0;
                f32x4 qv = {0.f, 0.f, 0.f, 0.f};
#pragma unroll
                for (int bj = 0; bj < 2; ++bj) { const u32x4 w0 = b[ai][m][bj];
                    const f32x4 x0 = (f32x4){__uint_as_float(w0.x << 16), __uint_as_float(w0.x & 0xffff0000u), __uint_as_float(w0.y << 16), __uint_as_float(w0.y & 0xffff0000u)} + acc[ai][bj][m][0];
                    const f32x4 x1 = (f32x4){__uint_as_float(w0.z << 16), __uint_as_float(w0.z & 0xffff0000u), __uint_as_float(w0.w << 16), __uint_as_float(w0.w & 0xffff0000u)} + acc[ai][bj][m][1];
                    qv = x0 * x0 + qv; qv = x1 * x1 + qv;
                    u32x4 w; w.x = cvt_pk_bf16(x0.x, x0.y); w.y = cvt_pk_bf16(x0.z, x0.w); w.z = cvt_pk_bf16(x1.x, x1.y); w.w = cvt_pk_bf16(x1.z, x1.w);
                    *(u32x4*)(rowp + bj * HALF) = w; }
                if (ss) { float q = (qv.x + qv.y) + (qv.z + qv.w); q += __int_as_float(__builtin_amdgcn_ds_bpermute((lane ^ 16) << 2, __float_as_int(q))); q += __int_as_float(__builtin_amdgcn_ds_bpermute((lane ^ 32) << 2, __float_as_int(q)));
                    if (fq == 0) (void)__hip_atomic_fetch_add(ss + row, f32_to_u64(q * SS_SCALE + 0.5f), __ATOMIC_RELAXED, __HIP_MEMORY_SCOPE_AGENT); } }
    }
};
struct EpiF32 {
    static constexpr bool PERM = false, AFTER_DRAIN = false; static constexpr bool PEEL = true; static constexpr int NST = 32;
    float* out; int ldc; const u64* ss;
    typedef PreSS Pre;
    __device__ __forceinline__ void prefetch(Pre& p, const Unit& u, LAS unsigned char* lds, int ui, int wid, int lane) const { prefetch_ss(p, ss, u, lds, ui, wid, lane); }
    __device__ __forceinline__ void operator()(const f32x4 (&acc)[2][2][4][2], const Unit& u, int wr, int wc, int fr, int fq, const Pre& pre, LAS unsigned char* lds) const {
        const int col0 = u.pn * BM + wc * 32 + 4 * fq;
#pragma unroll
        for (int ai = 0; ai < 2; ++ai)
#pragma unroll
            for (int m = 0; m < 4; ++m) { const int row = u.pm * BM + ai * HALF + wr * 64 + m * 16 + fr; float* rowp = out + (size_t)row * ldc + col0; const float rs = pre_rstd(pre, ss, lds, ai * HALF + wr * 64 + m * 16 + fr);
#pragma unroll
                for (int bj = 0; bj < 2; ++bj)
#pragma unroll
                    for (int n = 0; n < 2; ++n) *(f32x4*)(rowp + bj * HALF + n * 16) = acc[ai][bj][m][n] * rs; }
    }
};

struct EpiLat {
    static constexpr bool PERM = true, AFTER_DRAIN = false; static constexpr bool PEEL = false; static constexpr int NST = 16;
    bf16_t* CQ; bf16_t* CKV; bf16_t* KR; const u64* ss; u64* ssq; u64* sskv; const float* tabc; const float* tabs;
    typedef PreSS Pre;
    __device__ __forceinline__ void prefetch(Pre& p, const Unit& u, LAS unsigned char* lds, int ui, int wid, int lane) const { prefetch_ss(p, ss, u, lds, ui, wid, lane); }
    __device__ __forceinline__ void operator()(const f32x4 (&acc)[2][2][4][2], const Unit& u, int wr, int wc, int fr, int fq, const Pre& pre, LAS unsigned char* lds) const {
        const int lane = fq * 16 + fr;
#pragma unroll
        for (int bj = 0; bj < 2; ++bj) {
            const int cb = u.pn * BM + bj * HALF + wc * 32, col = cb + 8 * fq;
            const int region = cb < QLR ? 0 : (cb < QLR + KVL ? 1 : 2);
#pragma unroll
            for (int ai = 0; ai < 2; ++ai)
#pragma unroll
                for (int m = 0; m < 4; ++m) { const int row = u.pm * BM + ai * HALF + wr * 64 + m * 16 + fr; const float rs = pre_rstd(pre, ss, lds, ai * HALF + wr * 64 + m * 16 + fr);
                    f32x4 v0 = acc[ai][bj][m][0] * rs, v1 = acc[ai][bj][m][1] * rs;
                    if (region == 2) { const int pos = row_pos(row), j0 = (cb - QLR - KVL) / 2 + 4 * fq; const f32x4 c = *(const f32x4*)(tabc + pos * 32 + j0), s = *(const f32x4*)(tabs + pos * 32 + j0);
                        const f32x4 o1 = v0 * c - v1 * s, o2 = v0 * s + v1 * c; v0 = o1; v1 = o2; }
                    u32x4 w; w.x = cvt_pk_bf16(v0[0], v0[1]); w.y = cvt_pk_bf16(v0[2], v0[3]); w.z = cvt_pk_bf16(v1[0], v1[1]); w.w = cvt_pk_bf16(v1[2], v1[3]);
                    if (region == 0) *(u32x4*)(CQ + (size_t)row * QLP + col) = w;
                    else if (region == 1) { *(u32x4*)(CKV + (size_t)row * KVL + (col - QLR)) = w; if (cb < QLP) { unsigned zz = 0u; asm volatile("" : "+v"(zz)); *(u32x4*)(CQ + (size_t)row * QLP + col) = (u32x4){zz, zz, zz, zz}; } }
                    else *(u32x4*)(KR + (size_t)row * 64 + (col - QLR - KVL)) = w;
                    if (region < 2) { float q = ((v0.x * v0.x + v0.y * v0.y) + (v0.z * v0.z + v0.w * v0.w)) + ((v1.x * v1.x + v1.y * v1.y) + (v1.z * v1.z + v1.w * v1.w));
                        q += __int_as_float(__builtin_amdgcn_ds_bpermute((lane ^ 16) << 2, __float_as_int(q))); q += __int_as_float(__builtin_amdgcn_ds_bpermute((lane ^ 32) << 2, __float_as_int(q)));
                        if (fq == 0) (void)__hip_atomic_fetch_add((region == 0 ? ssq : sskv) + row, f32_to_u64(q * SS_SCALE + 0.5f), __ATOMIC_RELAXED, __HIP_MEMORY_SCOPE_AGENT); } }
        }
    }
};

template <class Epi, class Sched, bool ALIGN_EPI = true, bool PEELX = true>
__device__ __forceinline__ void gemm_phase(LAS unsigned char* lds, const Gemm g, const Sched& S, const Epi& E, int wave0) {
    const int lane = fresh_lane(), wid = wave0, tid = wid * 64 + lane;
    const int wr = wid >> 2, wc = wid & 3, fr = lane & 15, fq = lane >> 4;
    const int K = g.K, nt = K / BK;
    unsigned voffA, voffB;
    { int R, C; stage_rc(tid * 16, R, C); const int Rb = Epi::PERM ? ((R & ~31) + perm32(R & 31)) : R;
      voffA = (unsigned)(R * K + C) * 2u; voffB = (unsigned)(Rb * K + C) * 2u; }
    const size_t rstep = (size_t)64 * K * 2;
    const size_t kstep = (size_t)(BK * 2);
    const size_t hstep = (size_t)HALF * K * 2;
    const size_t tstep = 2 * hstep;
    const unsigned ldsw = (unsigned)wid * 1024u;
    const int aoff = lds_byte(wr * 64 + fr, fq * 8), boff = lds_byte(wc * 32 + fr, fq * 8);
#define PG8_SA(b, h) (((b) * 2 + (h)) * HTB)
#define PG8_SB(b, h) ((4 + (b) * 2 + (h)) * HTB)
#define PG8_STAGE(bufoff, gbase, voff) do { _Pragma("unroll") for (int _i = 0; _i < 2; ++_i) \
        __builtin_amdgcn_global_load_lds((const unsigned*)((const char*)(gbase) + _i * rstep + (voff)), (LAS unsigned*)(lds + (bufoff) + ldsw + _i * 8192), 16, 0, 0); } while (0)
#define PG8_LDA(dst, b, h) do { _Pragma("unroll") for (int m = 0; m < 4; ++m) _Pragma("unroll") for (int k = 0; k < 2; ++k) dst[m][k] = *(const LAS bf16x8*)(lds + PG8_SA(b, h) + aoff + m * 2048 + k * 1024); } while (0)
#define PG8_LDB(dst, b, h) do { _Pragma("unroll") for (int n = 0; n < 2; ++n) _Pragma("unroll") for (int k = 0; k < 2; ++k) dst[n][k] = *(const LAS bf16x8*)(lds + PG8_SB(b, h) + boff + n * 2048 + k * 1024); } while (0)
#define PG8_MMA(ai, bj, At, Bt) do { __builtin_amdgcn_s_setprio(1); _Pragma("unroll") for (int m = 0; m < 4; ++m) _Pragma("unroll") for (int n = 0; n < 2; ++n) _Pragma("unroll") for (int k = 0; k < 2; ++k) \
        acc[ai][bj][m][n] = __builtin_amdgcn_mfma_f32_16x16x32_bf16(Bt[n][k], At[m][k], acc[ai][bj][m][n], 0, 0, 0); __builtin_amdgcn_s_setprio(0); } while (0)
#define PG8_WAIT_V(n) asm volatile("s_waitcnt vmcnt(%0)" :: "n"(n) : "memory")
#define PG8_WAIT_L(n) asm volatile("s_waitcnt lgkmcnt(" #n ")" ::: "memory")
#define PG8_BAR __builtin_amdgcn_s_barrier()
#define PG8_SCHED __builtin_amdgcn_sched_barrier(0)
    Unit cur, nxt; int ui = 0;
    if (!S.next(0, cur)) return;
    f32x4 acc[2][2][4][2];
#pragma unroll
    for (int a = 0; a < 2; ++a)
#pragma unroll
        for (int b = 0; b < 2; ++b)
#pragma unroll
            for (int m = 0; m < 4; ++m)
#pragma unroll
                for (int n = 0; n < 2; ++n) acc[a][b][m][n] = (f32x4){0.f, 0.f, 0.f, 0.f};
    bf16x8 At[4][2], B0[2][2], B1[2][2];
    const char* cA = (const char*)g.A + (size_t)cur.pm * tstep; const char* cB = (const char*)g.Bt + (size_t)cur.pn * tstep;
    S.a_ready(cur);
    typename Epi::Pre pre; E.prefetch(pre, cur, lds, ui, wid, fresh_lane());
    PG8_STAGE(PG8_SB(0, 0), cB, voffB); PG8_STAGE(PG8_SB(0, 1), cB + hstep, voffB); PG8_STAGE(PG8_SA(0, 0), cA, voffA); PG8_STAGE(PG8_SA(0, 1), cA + hstep, voffA);
    if (wr == 1) PG8_BAR;
    PG8_WAIT_V(2); PG8_BAR;
    PG8_STAGE(PG8_SB(1, 0), cB + kstep, voffB); PG8_STAGE(PG8_SA(1, 0), cA + kstep, voffA); PG8_STAGE(PG8_SB(1, 1), cB + hstep + kstep, voffB);
    PG8_WAIT_V(0); PG8_BAR;
    for (;;) {
        const bool has_next = S.next(ui + 1, nxt);
        const char* nA = has_next ? (const char*)g.A + (size_t)nxt.pm * tstep : cA; const char* nB = has_next ? (const char*)g.Bt + (size_t)nxt.pn * tstep : cB;
#define PG8_ITER(t, W12) do { \
            const bool last = ((t) == nt - 2); \
            const char* a1 = cA + (size_t)((t) + 1) * kstep; \
            const char* a2 = last ? nA : cA + (size_t)((t) + 2) * kstep; const char* b2 = last ? nB : cB + (size_t)((t) + 2) * kstep; \
            const char* a3 = a2 + kstep; const char* b3 = b2 + kstep; \
            if (last && has_next) S.a_ready(nxt); \
            PG8_LDB(B0, 0, 0); PG8_LDB(B1, 0, 1); PG8_SCHED; PG8_LDA(At, 0, 0); PG8_STAGE(PG8_SA(1, 1), a1 + hstep, voffA); \
            PG8_WAIT_V(W12); PG8_WAIT_L(0); PG8_BAR; PG8_MMA(0, 0, At, B0); PG8_MMA(0, 1, At, B1); PG8_BAR; PG8_SCHED; \
            PG8_LDA(At, 0, 1); PG8_STAGE(PG8_SB(0, 0), b2, voffB); PG8_STAGE(PG8_SB(0, 1), b2 + hstep, voffB); PG8_STAGE(PG8_SA(0, 0), a2, voffA); \
            PG8_WAIT_V(W12); PG8_WAIT_L(0); PG8_BAR; PG8_MMA(1, 0, At, B0); PG8_MMA(1, 1, At, B1); PG8_BAR; PG8_SCHED; \
            PG8_LDB(B0, 1, 0); PG8_LDB(B1, 1, 1); PG8_SCHED; PG8_LDA(At, 1, 0); PG8_STAGE(PG8_SA(0, 1), a2 + hstep, voffA); \
            PG8_WAIT_V(8); PG8_WAIT_L(0); PG8_BAR; PG8_MMA(0, 0, At, B0); PG8_MMA(0, 1, At, B1); PG8_BAR; PG8_SCHED; \
            PG8_LDA(At, 1, 1); PG8_STAGE(PG8_SB(1, 0), b3, voffB); PG8_STAGE(PG8_SB(1, 1), b3 + hstep, voffB); PG8_STAGE(PG8_SA(1, 0), a3, voffA); \
            PG8_WAIT_V(8); PG8_WAIT_L(0); PG8_BAR; PG8_MMA(1, 0, At, B0); PG8_MMA(1, 1, At, B1); PG8_BAR; PG8_SCHED; } while (0)
        if constexpr (Epi::PEEL && PEELX) { PG8_ITER(0, 8 + Epi::NST); for (int t = 2; t < nt; t += 2) PG8_ITER(t, 8); }
        else { for (int t = 0; t < nt; t += 2) PG8_ITER(t, 8); }
#undef PG8_ITER
        if constexpr (ALIGN_EPI) { if (wr == 0) PG8_BAR; }
        { const int le_ = fresh_lane(); E(acc, cur, wr, wc, le_ & 15, le_ >> 4, pre, lds); } S.done(cur);
        if (!has_next) break;
#pragma unroll
        for (int a = 0; a < 2; ++a)
#pragma unroll
            for (int b = 0; b < 2; ++b)
#pragma unroll
                for (int m = 0; m < 4; ++m)
#pragma unroll
                    for (int n = 0; n < 2; ++n) acc[a][b][m][n] = (f32x4){0.f, 0.f, 0.f, 0.f};
        cur = nxt; cA = nA; cB = nB; ++ui; E.prefetch(pre, cur, lds, ui, wid, fresh_lane());
        if constexpr (ALIGN_EPI) { if (wr == 1) PG8_BAR; }
    }
    PG8_WAIT_V(0);
    if constexpr (!ALIGN_EPI) { if (wr == 0) PG8_BAR; }
    PG8_BAR;
#undef PG8_SA
#undef PG8_SB
#undef PG8_STAGE
#undef PG8_LDA
#undef PG8_LDB
#undef PG8_MMA
#undef PG8_WAIT_V
#undef PG8_WAIT_L
#undef PG8_BAR
#undef PG8_SCHED
}
}

#define SBAR() __builtin_amdgcn_sched_barrier(0)
__device__ __forceinline__ int crow(int r, int hi) { return (r & 3) + 8 * (r >> 2) + 4 * hi; }
__device__ __forceinline__ int v_st(int k, int c) { const int kk = (k & ~0xC) | ((k & 4) << 1) | ((k & 8) >> 1); return ((kk >> 3) * 4 + (c >> 5)) * 512 + ((kk & 7) * 32 + (c & 31)) * 2; }
__device__ __forceinline__ int v_rd_base(int lane) { return ((lane & 3) << 3) | (((lane >> 2) & 3) << 6) | (((lane >> 4) & 1) << 5) | (((lane >> 5) & 1) << 8); }
constexpr int v_rd_off(int d0, int ks, int half) { return d0 * 512 + ks * 4096 + half * 2048; }
template <int OFF> __device__ __forceinline__ s16x4 tr_read(int vb) {
  s16x4 r; asm volatile("ds_read_b64_tr_b16 %0, %1 offset:%2" : "=&v"(r) : "v"(vb), "i"(OFF) : "memory"); return r;
}
template <int D0> __device__ __forceinline__ void pv_one(f32x16& od, int vb, bf16x8 pa0, bf16x8 pa1, bf16x8 pa2, bf16x8 pa3) {
  const s16x4 l0 = tr_read<v_rd_off(D0, 0, 0)>(vb), h0 = tr_read<v_rd_off(D0, 0, 1)>(vb), l1 = tr_read<v_rd_off(D0, 1, 0)>(vb), h1 = tr_read<v_rd_off(D0, 1, 1)>(vb);
  const s16x4 l2 = tr_read<v_rd_off(D0, 2, 0)>(vb), h2 = tr_read<v_rd_off(D0, 2, 1)>(vb), l3 = tr_read<v_rd_off(D0, 3, 0)>(vb), h3 = tr_read<v_rd_off(D0, 3, 1)>(vb);
  asm volatile("s_waitcnt lgkmcnt(0)" ::: "memory"); SBAR();
#define PK(L, H) (bf16x8){L[0], L[1], L[2], L[3], H[0], H[1], H[2], H[3]}
  od = __builtin_amdgcn_mfma_f32_32x32x16_bf16(pa0, PK(l0, h0), od, 0, 0, 0);
  od = __builtin_amdgcn_mfma_f32_32x32x16_bf16(pa1, PK(l1, h1), od, 0, 0, 0);
  od = __builtin_amdgcn_mfma_f32_32x32x16_bf16(pa2, PK(l2, h2), od, 0, 0, 0);
  od = __builtin_amdgcn_mfma_f32_32x32x16_bf16(pa3, PK(l3, h3), od, 0, 0, 0);
#undef PK
}
__device__ __forceinline__ void pv_d0(f32x16* o, int vb, bf16x8 pa0, bf16x8 pa1, bf16x8 pa2, bf16x8 pa3) {
  pv_one<0>(o[0], vb, pa0, pa1, pa2, pa3); pv_one<1>(o[1], vb, pa0, pa1, pa2, pa3); pv_one<2>(o[2], vb, pa0, pa1, pa2, pa3); pv_one<3>(o[3], vb, pa0, pa1, pa2, pa3);
}
#define PK4(P, BASE, OUT) do { unsigned a0 = cvt_pk_bf16(P[BASE + 0], P[BASE + 1]), a1 = cvt_pk_bf16(P[BASE + 2], P[BASE + 3]);   \
    unsigned b0 = cvt_pk_bf16(P[BASE + 4], P[BASE + 5]), b1 = cvt_pk_bf16(P[BASE + 6], P[BASE + 7]);                              \
    auto r0 = __builtin_amdgcn_permlane32_swap(a0, b0, false, false); auto r1 = __builtin_amdgcn_permlane32_swap(a1, b1, false, false); \
    u32x4 w = {r0[0], r1[0], r0[1], r1[1]}; OUT = *reinterpret_cast<bf16x8*>(&w); } while (0)
__device__ __forceinline__ float half_swap_max(float v) { auto rr = __builtin_amdgcn_permlane32_swap(__float_as_uint(v), __float_as_uint(v), false, false); return fmaxf(__uint_as_float(rr[0]), __uint_as_float(rr[1])); }
__device__ __forceinline__ float half_swap_add(float v) { auto rr = __builtin_amdgcn_permlane32_swap(__float_as_uint(v), __float_as_uint(v), false, false); return __uint_as_float(rr[0]) + __uint_as_float(rr[1]); }

template <int D0, int KS0> __device__ __forceinline__ void pv_half_one(f32x16& od, int vb, bf16x8 pa, bf16x8 pb) {
  const s16x4 l0 = tr_read<v_rd_off(D0, KS0, 0)>(vb), h0 = tr_read<v_rd_off(D0, KS0, 1)>(vb), l1 = tr_read<v_rd_off(D0, KS0 + 1, 0)>(vb), h1 = tr_read<v_rd_off(D0, KS0 + 1, 1)>(vb);
  asm volatile("s_waitcnt lgkmcnt(0)" ::: "memory"); SBAR();
#define PK(L, H) (bf16x8){L[0], L[1], L[2], L[3], H[0], H[1], H[2], H[3]}
  od = __builtin_amdgcn_mfma_f32_32x32x16_bf16(pa, PK(l0, h0), od, 0, 0, 0);
  od = __builtin_amdgcn_mfma_f32_32x32x16_bf16(pb, PK(l1, h1), od, 0, 0, 0);
#undef PK
}
template <int KS0> __device__ __forceinline__ void pv_half(f32x16* o, int vb, bf16x8 pa, bf16x8 pb) {
  pv_half_one<0, KS0>(o[0], vb, pa, pb); pv_half_one<1, KS0>(o[1], vb, pa, pb); pv_half_one<2, KS0>(o[2], vb, pa, pb); pv_half_one<3, KS0>(o[3], vb, pa, pb);
}

namespace dwa {
constexpr int SLOT = 32768;
constexpr int OFF_WS = 2 * SLOT, OFF_STG = OFF_WS + 8 * 256, LDS_BYTES = OFF_STG + 8 * 8192;
constexpr float C_QK = 0.08838834764831845f * LOG2E;
#define KSWZ128(row, colB) ((row) * 256 + ((colB) ^ (((row) & 15) << 4)))
__device__ __forceinline__ void dw_glds16(const void* gsrc, unsigned lds_dst) { unsigned keep;
  asm volatile("s_mov_b32 %0, m0\n\ts_mov_b32 m0, %2\n\ts_nop 0\n\tglobal_load_lds_dwordx4 %1, off\n\ts_mov_b32 m0, %0" : "=&s"(keep) : "v"(gsrc), "s"(lds_dst) : "memory"); }
constexpr float DW_THR = 8.f / C_QK;
template <int KT, bool U0, bool U1, bool FIRST>
__device__ __forceinline__ void tile(f32x16 (&o)[4], float& m_reg, float& l_reg, const bf16x8 (&qr)[8], const char* Kt, int vslot, float* al_l, int qh, float nsl) {
  const int ln_ = fresh_lane(), r32 = ln_ & 31, hi = ln_ >> 5, vbase = vslot + v_rd_base(ln_);
  const float base = (float)(32 * qh + r32 - 4 * hi);
  f32x16 p0 = {}, p1 = {};
  {
    const char* k0 = Kt + r32 * 256, * k1 = k0 + 32 * 256; const int sw = (r32 & 15) << 4, hb = hi * 16;
#define KRD(d0_, A_, B_) do { const int cb_ = ((d0_) * 32 + hb) ^ sw; if (U0) A_ = *reinterpret_cast<const bf16x8*>(k0 + cb_); if (U1) B_ = *reinterpret_cast<const bf16x8*>(k1 + cb_); } while (0)
#define KMM(d0_, A_, B_) do { if (U0) p0 = __builtin_amdgcn_mfma_f32_32x32x16_bf16(A_, qr[d0_], p0, 0, 0, 0); if (U1) p1 = __builtin_amdgcn_mfma_f32_32x32x16_bf16(B_, qr[d0_], p1, 0, 0, 0); } while (0)
    bf16x8 a0 = {}, b0 = {}, a1 = {}, b1 = {}, a2 = {}, b2 = {};
    KRD(0, a0, b0); KRD(1, a1, b1);
    KRD(2, a2, b2); SBAR(); KMM(0, a0, b0); KRD(3, a0, b0); SBAR(); KMM(1, a1, b1); KRD(4, a1, b1); SBAR(); KMM(2, a2, b2);
    KRD(5, a2, b2); SBAR(); KMM(3, a0, b0); KRD(6, a0, b0); SBAR(); KMM(4, a1, b1); KRD(7, a1, b1); SBAR(); KMM(5, a2, b2);
    SBAR(); KMM(6, a0, b0); SBAR(); KMM(7, a1, b1);
#undef KRD
#undef KMM
  }
  float pmax = -1e30f;
#define DW_SCORE(P, HALF) do { _Pragma("unroll") for (int rr = 0; rr < 16; ++rr) { const float d = base - (float)((rr & 3) + 8 * (rr >> 2) + 32 * (HALF));     \
      if (KT == 0) P[rr] = fmaf(__builtin_fabsf(d), nsl, P[rr]);                                    \
      else if (KT < 0) P[rr] = d <= 0.f ? fmaf(d + 64.f, nsl, P[rr]) : -1e30f;                      \
      else P[rr] = d >= 0.f ? fmaf(64.f - d, nsl, P[rr]) : -1e30f;                                  \
      pmax = fmaxf(pmax, P[rr]); } } while (0)
  if (U0) DW_SCORE(p0, 0);
  if (U1) DW_SCORE(p1, 1);
#undef DW_SCORE
  pmax = half_swap_max(pmax);
  float alpha = 1.f;
  const bool keep = !FIRST && __all(pmax - m_reg <= DW_THR);
  if (!keep) { const float mn = fmaxf(m_reg, pmax); alpha = __builtin_amdgcn_exp2f((m_reg - mn) * C_QK); m_reg = mn; }
  const float mC = -m_reg * C_QK;
  float ps = 0.f;
#pragma unroll
  for (int rr = 0; rr < 16; ++rr) { if (U0) { p0[rr] = __builtin_amdgcn_exp2f(fmaf(p0[rr], C_QK, mC)); ps += p0[rr]; } if (U1) { p1[rr] = __builtin_amdgcn_exp2f(fmaf(p1[rr], C_QK, mC)); ps += p1[rr]; } }
  ps = half_swap_add(ps); l_reg = l_reg * alpha + ps;
  bf16x8 pa0 = {}, pa1 = {}, pa2 = {}, pa3 = {};
  if (U0) { PK4(p0, 0, pa0); PK4(p0, 8, pa1); }
  if (U1) { PK4(p1, 0, pa2); PK4(p1, 8, pa3); }
  if (!FIRST && !keep) {
    if (hi == 0) al_l[r32] = alpha; asm volatile("s_waitcnt lgkmcnt(0)" ::: "memory");
#pragma unroll
    for (int rr = 0; rr < 16; ++rr) { const float al = al_l[crow(rr, hi)];
#pragma unroll
      for (int d = 0; d < 4; ++d) o[d][rr] *= al; }
    asm volatile("s_waitcnt lgkmcnt(0)" ::: "memory"); }
  SBAR();
  if (U0 && U1) pv_d0(o, vbase, pa0, pa1, pa2, pa3);
  else if (U0) pv_half<0>(o, vbase, pa0, pa1);
  else pv_half<2>(o, vbase, pa2, pa3);
}
__device__ __forceinline__ void item(const bf16_t* __restrict__ qkvs, bf16_t* __restrict__ og, float* __restrict__ lse, int seqbase, int S, int g, int dil, int res, int n0, int L, int h, char* lds, int wave0) {
  const int lane = fresh_lane(), wid = wave0, tid = wid * 64 + lane, r32 = lane & 31, hi = lane >> 5;
  const int qh = wid & 1;
  const int nblk = (S / dil) >> 6, nend = n0 + L;
  const bf16_t* Qs = qkvs + ((size_t)((g * 3 + 0) * NH + h) * CHUNK + seqbase) * 128;
  const bf16_t* Ks = qkvs + ((size_t)((g * 3 + 1) * NH + h) * CHUNK + seqbase) * 128;
  const bf16_t* Vs = qkvs + ((size_t)((g * 3 + 2) * NH + h) * CHUNK + seqbase) * 128;
  const int a = 32 * qh + r32;
  int nb = n0 + (wid >> 1);
  bf16x8 qr[8];
#define DW_QLOAD() do { const int lq_ = fresh_lane(); const long qt_ = (long)(64 * nb + 32 * qh + (lq_ & 31)) * dil + res; const int hq_ = lq_ >> 5; _Pragma("unroll") for (int d0 = 0; d0 < 8; ++d0) qr[d0] = *(const bf16x8*)(Qs + qt_ * 128 + d0 * 16 + hq_ * 8); } while (0)
  DW_QLOAD();
  float* al_l = (float*)(lds + OFF_WS + wid * 256);
  float m_reg = -1e30f, l_reg = 0.f; f32x16 o[4] = {};
  const float nsl = -__builtin_amdgcn_exp2f(-0.5f * (float)(h + 1)) * (float)dil * (LOG2E / C_QK);
  const int kmin = n0 == 0 ? 0 : n0 - 1, kmax = nend < nblk ? nend : nblk - 1;
  int doff[4];
#pragma unroll
  for (int i = 0; i < 4; ++i) { const int ob = 1024 * ((4 * wid + i) & 15) + 16 * lane;
    if (wid < 4) { const int row = ob >> 8, cs = (ob & 255) >> 4, ch = cs ^ (row & 15); doff[i] = row * dil * 128 + ch * 8; }
    else { const int sub = ob >> 9, within = ob & 511, kk = (sub >> 2) * 8 + (within >> 6), kq = (kk & ~0xC) | ((kk & 4) << 1) | ((kk & 8) >> 1), c = (sub & 3) * 32 + ((within & 63) >> 1); doff[i] = kq * dil * 128 + c; } }
  const bf16_t* const dbase = (wid < 4 ? Ks : Vs) + (long)res * 128;
#define DW_DMA(k, slot) do { const bf16_t* tb_ = dbase + (long)(64 * (k)) * dil * 128; const unsigned d_ = (unsigned)__builtin_amdgcn_readfirstlane((unsigned)(uintptr_t)(lds + (slot) * SLOT + 4096 * wid)); \
    dw_glds16(tb_ + doff[0], d_); dw_glds16(tb_ + doff[1], d_ + 1024u); dw_glds16(tb_ + doff[2], d_ + 2048u); dw_glds16(tb_ + doff[3], d_ + 3072u); } while (0)
#define DW_WAIT_BAR() asm volatile("s_waitcnt vmcnt(0) lgkmcnt(0)\n\ts_barrier" ::: "memory")
#define DW_EPI() do { const int ln_ = fresh_lane(), r32e = ln_ & 31, hie = ln_ >> 5;     \
    if (hie == 0) al_l[r32e] = __builtin_amdgcn_rcpf(l_reg); asm volatile("s_waitcnt lgkmcnt(0)" ::: "memory"); \
    bf16_t* stg = (bf16_t*)(lds + OFF_STG + wid * 8192); \
    _Pragma("unroll") for (int rr = 0; rr < 16; ++rr) { const int row = crow(rr, hie); const float li = al_l[row]; \
      _Pragma("unroll") for (int d = 0; d < 4; ++d) { const unsigned w = cvt_pk_bf16(o[d][rr] * li, 0.f); stg[row * 128 + d * 32 + r32e] = (bf16_t)(w & 0xffffu); } } \
    asm volatile("s_waitcnt lgkmcnt(0)" ::: "memory"); \
    const int er = ln_ >> 4, ec = (ln_ & 15) * 8; \
    _Pragma("unroll") for (int i = 0; i < 8; ++i) { const int row = er + 4 * i; const long tok = seqbase + (long)(64 * nb + 32 * qh + row) * dil + res; \
      *(u32x4*)(og + (tok * 3 + g) * DM + h * 128 + ec) = *(const u32x4*)(stg + row * 128 + ec); } \
    if (hie == 0) lse[((seqbase + (long)(64 * nb + 32 * qh + r32e) * dil + res) * 3 + g) * NH + h] = m_reg * C_QK + __builtin_amdgcn_logf(l_reg);     \
    asm volatile("s_waitcnt lgkmcnt(0)" ::: "memory"); } while (0)
  DW_DMA(kmin, kmin & 1); DW_WAIT_BAR();
  for (int k = kmin; k <= kmax; ++k) {
    if (k < kmax) DW_DMA(k + 1, (k + 1) & 1);
    const int kt = k - nb;
    if (nb < nend && kt >= -1 && kt <= 1) {
      const char* Kt = lds + (k & 1) * SLOT; const int vb_ = (int)(uintptr_t)(lds + (k & 1) * SLOT + 16384);
      if (kt == 0) { if (nb == 0) tile<0, true, true, true>(o, m_reg, l_reg, qr, Kt, vb_, al_l, qh, nsl); else tile<0, true, true, false>(o, m_reg, l_reg, qr, Kt, vb_, al_l, qh, nsl); }
      else if (kt < 0) { if (qh) tile<-1, false, true, true>(o, m_reg, l_reg, qr, Kt, vb_, al_l, qh, nsl); else tile<-1, true, true, true>(o, m_reg, l_reg, qr, Kt, vb_, al_l, qh, nsl); }
      else { if (qh) tile<1, true, true, false>(o, m_reg, l_reg, qr, Kt, vb_, al_l, qh, nsl); else tile<1, true, false, false>(o, m_reg, l_reg, qr, Kt, vb_, al_l, qh, nsl); }
    } else if (nb < nend && kt == 2) {
      DW_EPI();
      nb += 4;
      if (nb < nend) { DW_QLOAD(); m_reg = -1e30f; l_reg = 0.f;
#pragma unroll
        for (int d = 0; d < 4; ++d) o[d] = f32x16{}; }
    }
    DW_WAIT_BAR();
  }
  if (nb < nend) DW_EPI();
#undef DW_DMA
#undef DW_WAIT_BAR
#undef DW_QLOAD
#undef DW_EPI
}
}

namespace mla {
constexpr int NW = 8, QBLK = 32, KVBLK = 64;
constexpr float SCALE = 0.07216878364870322f;
constexpr float THR = 8.f;
constexpr int LDQ = NQ, LDKV = NKV, LDKR = 64, LDO = DM;
constexpr int SHM_V = KVBLK * 128 * 2, SHM_K = KVBLK * 192 * 2;
constexpr int OFF_V = 0, OFF_K = 2 * SHM_V, OFF_WS = 2 * SHM_V + 2 * SHM_K, OFF_QR = OFF_WS + NW * 64 * 4, LDS_BYTES = OFF_QR + NW * 4096;
#define KSWZ192(row, colB) ((row) * 384 + ((colB) ^ ((((row) >> 1) & 7) << 4)))

__device__ __forceinline__ void partialSM(f32x16& p0, f32x16& p1, float& m_reg, float& mn, float& alpha) {
  constexpr float C = SCALE * LOG2E;
  float pmax = p0[0];
#pragma unroll
  for (int r = 1; r < 16; ++r) pmax = fmaxf(pmax, p0[r]);
#pragma unroll
  for (int r = 0; r < 16; ++r) pmax = fmaxf(pmax, p1[r]);
  pmax = half_swap_max(pmax);
  if (__builtin_expect(__all(pmax - m_reg <= THR / SCALE), 1)) { mn = m_reg; alpha = 1.f; }
  else { mn = fmaxf(m_reg, pmax); alpha = __builtin_amdgcn_exp2f((m_reg - mn) * C); m_reg = mn; }
  const float mnC = -mn * C;
#pragma unroll
  for (int r = 0; r < 16; ++r) p0[r] = fmaf(p0[r], C, mnC);
#pragma unroll
  for (int r = 0; r < 16; ++r) p1[r] = fmaf(p1[r], C, mnC);
}
__device__ __forceinline__ void finishSM(f32x16& p0, f32x16& p1, float alpha, float& l_reg, bf16x8& pa0, bf16x8& pa1, bf16x8& pa2, bf16x8& pa3) {
#pragma unroll
  for (int r = 0; r < 16; ++r) p0[r] = __builtin_amdgcn_exp2f(p0[r]);
#pragma unroll
  for (int r = 0; r < 16; ++r) p1[r] = __builtin_amdgcn_exp2f(p1[r]);
  float ps = 0;
#pragma unroll
  for (int r = 0; r < 16; ++r) ps += p0[r];
#pragma unroll
  for (int r = 0; r < 16; ++r) ps += p1[r];
  ps = half_swap_add(ps);
  l_reg = l_reg * alpha + ps;
  PK4(p0, 0, pa0); PK4(p0, 8, pa1); PK4(p1, 0, pa2); PK4(p1, 8, pa3);
}
__device__ __forceinline__ void qkt(f32x16& p0, f32x16& p1, const char* Ks, const bf16x8* qr, const char* qrl, int r32, int hi) {
  p0 = f32x16{}; p1 = f32x16{};
#pragma unroll
  for (int d0 = 0; d0 < 12; ++d0) { const int cb = (d0 * 16 + hi * 8) * 2;
    const bf16x8 b0 = *reinterpret_cast<const bf16x8*>(Ks + KSWZ192(r32, cb));
    const bf16x8 b1 = *reinterpret_cast<const bf16x8*>(Ks + KSWZ192(32 + r32, cb));
    const bf16x8 qf = d0 < 8 ? qr[d0 < 8 ? d0 : 0] : *reinterpret_cast<const bf16x8*>(qrl + (d0 - 8) * 1024);
    p0 = __builtin_amdgcn_mfma_f32_32x32x16_bf16(b0, qf, p0, 0, 0, 0);
    p1 = __builtin_amdgcn_mfma_f32_32x32x16_bf16(b1, qf, p1, 0, 0, 0); }
}
__device__ __forceinline__ void qkt_fsm(f32x16& q0, f32x16& q1, const char* Ks, const bf16x8* qr, const char* qrl, int r32, int hi,
                                        f32x16& s0, f32x16& s1, float alpha, float& l_reg, bf16x8& pa0, bf16x8& pa1, bf16x8& pa2, bf16x8& pa3) {
  q0 = f32x16{}; q1 = f32x16{};
  const char* ka = Ks + r32 * 384, * kb = ka + 32 * 384; const int sw = ((r32 >> 1) & 7) << 4;
#define KF(d0_, A_, B_, Q_) do { const int cb_ = (((d0_) * 16 + hi * 8) * 2); const int o_ = (cb_ & ~127) | ((cb_ & 127) ^ sw); A_ = *reinterpret_cast<const bf16x8*>(ka + o_); B_ = *reinterpret_cast<const bf16x8*>(kb + o_); \
    if ((d0_) >= 8) Q_ = *reinterpret_cast<const bf16x8*>(qrl + ((d0_) - 8) * 1024); } while (0)
  bf16x8 a0, b0, qf0 = {};
  float ps = 0.f;
  KF(0, a0, b0, qf0);
#define STEP(d0_, SLICE) do { \
    q0 = __builtin_amdgcn_mfma_f32_32x32x16_bf16(a0, (d0_) < 8 ? qr[(d0_) < 8 ? (d0_) : 0] : qf0, q0, 0, 0, 0); q1 = __builtin_amdgcn_mfma_f32_32x32x16_bf16(b0, (d0_) < 8 ? qr[(d0_) < 8 ? (d0_) : 0] : qf0, q1, 0, 0, 0); \
    if ((d0_) < 11) KF((d0_) + 1, a0, b0, qf0); \
    SLICE; SBAR(); } while (0)
#define EX4(S_, i_) do { S_[i_] = __builtin_amdgcn_exp2f(S_[i_]); S_[(i_) + 1] = __builtin_amdgcn_exp2f(S_[(i_) + 1]); S_[(i_) + 2] = __builtin_amdgcn_exp2f(S_[(i_) + 2]); S_[(i_) + 3] = __builtin_amdgcn_exp2f(S_[(i_) + 3]); } while (0)
#define AD4(S_, i_) do { ps += S_[i_]; ps += S_[(i_) + 1]; ps += S_[(i_) + 2]; ps += S_[(i_) + 3]; } while (0)
  STEP(0, { EX4(s0, 0); });
  STEP(1, { EX4(s0, 4); AD4(s0, 0); });
  STEP(2, { EX4(s0, 8); AD4(s0, 4); });
  STEP(3, { EX4(s0, 12); AD4(s0, 8); });
  STEP(4, { AD4(s0, 12); PK4(s0, 0, pa0); });
  STEP(5, { PK4(s0, 8, pa1); EX4(s1, 0); });
  STEP(6, { EX4(s1, 4); AD4(s1, 0); });
  STEP(7, { EX4(s1, 8); AD4(s1, 4); });
  STEP(8, { EX4(s1, 12); AD4(s1, 8); });
  STEP(9, { AD4(s1, 12); PK4(s1, 0, pa2); });
  STEP(10, { PK4(s1, 8, pa3); });
  STEP(11, { ps = half_swap_add(ps); l_reg = l_reg * alpha + ps; });
#undef EX4
#undef AD4
#undef STEP
#undef KF
}
__device__ __forceinline__ void glds16(const void* gsrc, unsigned lds_dst) { unsigned keep;
  asm volatile("s_mov_b32 %0, m0\n\ts_mov_b32 m0, %2\n\ts_nop 0\n\tglobal_load_lds_dwordx4 %1, off\n\ts_mov_b32 m0, %0" : "=&s"(keep) : "v"(gsrc), "s"(lds_dst) : "memory"); }
#define MLA_WAIT_BAR() asm volatile("s_waitcnt vmcnt(0) lgkmcnt(0)\n\ts_barrier" ::: "memory")
__device__ __forceinline__ void attn_unit(const bf16_t* __restrict__ Qb, const bf16_t* __restrict__ Kn, const bf16_t* __restrict__ Kr, const bf16_t* __restrict__ Vh, bf16_t* __restrict__ Ob, int seq, char* lds, int wave0) {
  const int lane = fresh_lane(), wid = wave0, r32 = lane & 31, hi = lane >> 5;
  char* V_lds = lds + OFF_V; char* K_lds = lds + OFF_K;
  float* ws = (float*)(lds + OFF_WS) + wid * 64; float* li_l = ws; float* al_l = ws + 32;
  float m_reg = -1e30f, l_reg = 0; f32x16 o[4] = {}; bf16x8 qr[8];
  const bf16_t* Qw = Qb + (long)(wid * QBLK + r32) * LDQ + hi * 8;
#pragma unroll
  for (int d0 = 0; d0 < 8; ++d0) qr[d0] = *reinterpret_cast<const bf16x8*>(Qw + d0 * 16);
  char* const qrl = lds + OFF_QR + wid * 4096 + lane * 16;
#pragma unroll
  for (int d0 = 0; d0 < 4; ++d0) *reinterpret_cast<bf16x8*>(qrl + d0 * 1024) = *reinterpret_cast<const bf16x8*>(Qw + (8 + d0) * 16);
  const bf16_t* ksrc[3]; long kstep[3]; const bf16_t* vsrc[2];
#pragma unroll
  for (int i = 0; i < 3; ++i) { const int ob = 1024 * (3 * wid + i) + 16 * lane, row = ob / 384, cs = (ob % 384) >> 4, ch = (cs & ~7) | ((cs & 7) ^ ((row >> 1) & 7));
    const bool nope = ch < 16; ksrc[i] = nope ? Kn + (long)row * LDKV + ch * 8 : Kr + (long)row * LDKR + (ch - 16) * 8; kstep[i] = nope ? (long)KVBLK * LDKV : (long)KVBLK * LDKR; }
#pragma unroll
  for (int i = 0; i < 2; ++i) { const int ob = 1024 * (2 * wid + i) + 16 * lane, sub = ob >> 9, within = ob & 511, kk = (sub >> 2) * 8 + (within >> 6), k = (kk & ~0xC) | ((kk & 4) << 1) | ((kk & 8) >> 1), c = (sub & 3) * 32 + ((within & 63) >> 1);
    vsrc[i] = Vh + (long)k * LDKV + c; }
  const unsigned kdst = (unsigned)(uintptr_t)K_lds + 3072u * (unsigned)wid, vdst = (unsigned)(uintptr_t)V_lds + 2048u * (unsigned)wid;
#define DMA_K(t) do { const unsigned d_ = (unsigned)__builtin_amdgcn_readfirstlane(kdst + ((t) & 1) * SHM_K); \
    glds16(ksrc[0] + (long)(t) * kstep[0], d_); glds16(ksrc[1] + (long)(t) * kstep[1], d_ + 1024u); glds16(ksrc[2] + (long)(t) * kstep[2], d_ + 2048u); } while (0)
#define DMA_V(t) do { const unsigned d_ = (unsigned)__builtin_amdgcn_readfirstlane(vdst + ((t) & 1) * SHM_V); \
    glds16(vsrc[0] + (long)(t) * KVBLK * LDKV, d_); glds16(vsrc[1] + (long)(t) * KVBLK * LDKV, d_ + 1024u); } while (0)
  const int vb0 = (int)(uintptr_t)V_lds + v_rd_base(lane);
#define RESC(a) do { if (__any((a) < 1.f)) { if (hi == 0) al_l[r32] = (a); asm volatile("s_waitcnt lgkmcnt(0)" ::: "memory"); \
    _Pragma("unroll") for (int d = 0; d < 4; ++d) _Pragma("unroll") for (int r = 0; r < 16; ++r) o[d][r] *= al_l[crow(r, hi)]; } } while (0)
  f32x16 pA0, pA1, pB0, pB1; float mnA, mnB, alA, alB; bf16x8 pa0, pa1, pa2, pa3; const int NT = seq / KVBLK;
  DMA_K(0); MLA_WAIT_BAR();
  DMA_K(1); DMA_V(0);
  qkt(pA0, pA1, K_lds, qr, qrl, r32, hi); partialSM(pA0, pA1, m_reg, mnA, alA);
  for (int j = 1; j + 1 < NT; j += 2) {
    MLA_WAIT_BAR(); DMA_K(j + 1); DMA_V(j);
    SBAR(); __builtin_amdgcn_s_setprio(1); qkt_fsm(pB0, pB1, K_lds + SHM_K, qr, qrl, r32, hi, pA0, pA1, alA, l_reg, pa0, pa1, pa2, pa3); __builtin_amdgcn_s_setprio(0); SBAR();
    pv_d0(o, vb0, pa0, pa1, pa2, pa3); partialSM(pB0, pB1, m_reg, mnB, alB);
    RESC(alB);
    MLA_WAIT_BAR(); DMA_K(j + 2); DMA_V(j + 1);
    SBAR(); __builtin_amdgcn_s_setprio(1); qkt_fsm(pA0, pA1, K_lds, qr, qrl, r32, hi, pB0, pB1, alB, l_reg, pa0, pa1, pa2, pa3); __builtin_amdgcn_s_setprio(0); SBAR();
    pv_d0(o, vb0 + SHM_V, pa0, pa1, pa2, pa3); partialSM(pA0, pA1, m_reg, mnA, alA);
    RESC(alA);
  }
  MLA_WAIT_BAR(); DMA_V(NT - 1);
  SBAR(); __builtin_amdgcn_s_setprio(1); qkt_fsm(pB0, pB1, K_lds + SHM_K, qr, qrl, r32, hi, pA0, pA1, alA, l_reg, pa0, pa1, pa2, pa3); __builtin_amdgcn_s_setprio(0); SBAR();
  pv_d0(o, vb0, pa0, pa1, pa2, pa3); partialSM(pB0, pB1, m_reg, mnB, alB);
  RESC(alB);
  finishSM(pB0, pB1, alB, l_reg, pa0, pa1, pa2, pa3); SBAR();
  MLA_WAIT_BAR();
  pv_d0(o, vb0 + SHM_V, pa0, pa1, pa2, pa3);
  if (hi == 0) li_l[r32] = l_reg; asm volatile("s_waitcnt lgkmcnt(0)" ::: "memory");
  __syncthreads();
  bf16_t* stg = (bf16_t*)(lds + OFF_V + wid * 8192);
#pragma unroll
  for (int r = 0; r < 16; ++r) { const int row = crow(r, hi); const float li = __builtin_amdgcn_rcpf(li_l[row]);
#pragma unroll
    for (int d = 0; d < 4; ++d) { const unsigned w = cvt_pk_bf16(o[d][r] * li, 0.f); stg[row * 128 + d * 32 + r32] = (bf16_t)(w & 0xffffu); } }
  asm volatile("s_waitcnt lgkmcnt(0)" ::: "memory");
  const int er = lane >> 4, ec = (lane & 15) * 8;
#pragma unroll
  for (int i = 0; i < 8; ++i) { const int row = er + 4 * i;
    *(u32x4*)(Ob + (long)(wid * QBLK + row) * LDO + ec) = *(const u32x4*)(stg + row * 128 + ec); }
  asm volatile("s_waitcnt lgkmcnt(0)" ::: "memory");
  __syncthreads();
#undef DMA_K
#undef DMA_V
#undef RESC
}
}

constexpr int NWAVES = 8;
constexpr int NBLK = 256;
constexpr size_t MiB = 1u << 20;
constexpr size_t WS_CTL = 0, WS_SS = 1 * MiB, CTL_ZERO_BYTES = 4 * MiB;
constexpr size_t WS_ROPE_C = 150 * MiB, WS_ROPE_S = 151 * MiB;
constexpr size_t WS_W = 4 * MiB;
constexpr size_t W_QKV = WS_W, W_WA = WS_W, W_UQ = WS_W + 4 * MiB, W_UKV = WS_W + 8 * MiB;
constexpr size_t W_O = WS_W + 72 * MiB, W_GU = WS_W + 80 * MiB, W_DN = WS_W + 124 * MiB;
constexpr size_t WS_H = 152 * MiB;
constexpr size_t WS_S = 312 * MiB;
constexpr size_t S_QKV = WS_S, S_OG = WS_S + 288 * MiB, S_LSE = WS_S + 384 * MiB, S_OA = WS_S + 386 * MiB;
constexpr size_t S_ACT = WS_S;
constexpr size_t S_KV = WS_S, S_A = WS_S, S_CQ = WS_S + 320 * MiB, S_CKV = WS_S + 360 * MiB, S_KR = WS_S + 400 * MiB, S_Q = WS_S + 405 * MiB, S_OB = WS_S + 645 * MiB;
constexpr size_t WS_END = WS_S + 805 * MiB;
static_assert(S_OA + (size_t)T_ALL * DM * 2 <= WS_END && S_Q + (size_t)T_ALL * NQ * 2 <= S_OB && S_OB + (size_t)T_ALL * DM * 2 <= WS_END && S_ACT + (size_t)T_ALL * DFF * 2 <= WS_END, "d_ws map");
static_assert(W_DN + (size_t)DM * DFF * 2 <= WS_H && W_QKV + (size_t)NQKV * DM * 2 <= W_O && WS_H + (size_t)T_ALL * DM * 2 <= WS_S && WS_SS + (size_t)9 * T_ALL * 8 <= CTL_ZERO_BYTES && W_DN + (size_t)DM * DFF * 2 <= WS_ROPE_C, "d_ws map");
constexpr int CW_TMO = 0, CW_CODE = 1, CW_BAR = 4096;

constexpr int RING_OFF = 0, RING_BYTES = 146432;
constexpr int LDSCTL_OFF = RING_BYTES, MISC_OFF = LDSCTL_OFF + 320;
constexpr int LDS_BYTES = 147456;
static_assert(MISC_OFF + 128 <= LDS_BYTES && dwa::LDS_BYTES <= RING_BYTES && mla::LDS_BYTES <= RING_BYTES && pg8::STAGE_BYTES + 4096 <= RING_BYTES, "LDS map");

#define RLX_AGENT __ATOMIC_RELAXED, __HIP_MEMORY_SCOPE_AGENT
#define LDS_WAIT() asm volatile("s_waitcnt lgkmcnt(0)" ::: "memory")
#define VM_WAIT() asm volatile("s_waitcnt vmcnt(0)" ::: "memory")
__device__ __forceinline__ unsigned f2bf(float f) { unsigned u = __builtin_bit_cast(unsigned, f); return (u + 0x7fffu + ((u >> 16) & 1u)) >> 16; }
__device__ __forceinline__ unsigned pk2(float lo, float hi) { return f2bf(lo) | (f2bf(hi) << 16); }

#define XB_TMO      128
#define XB_XCNT(j)  (256  + 64 * (j))
#define XB_XSUB(j)  (1280 + 64 * (j))
#define XB_XGEN(j)  (2304 + 64 * (j))
#define XB_TOP      3328
#define XB_TOPGEN   3392
#define XCD_BAR_WORDS 3456
#define XB_SPIN_CAP (1u << 18)
__device__ __forceinline__ unsigned xb_ld(unsigned* p)              { return __hip_atomic_load(p, __ATOMIC_RELAXED, __HIP_MEMORY_SCOPE_AGENT); }
__device__ __forceinline__ unsigned xb_add(unsigned* p, unsigned v) { return __hip_atomic_fetch_add(p, v, __ATOMIC_RELAXED, __HIP_MEMORY_SCOPE_AGENT); }
__device__ __forceinline__ unsigned xb_xcc_id() { return (unsigned)__builtin_amdgcn_s_getreg((3 << 11) | 20) & 0xFu; }
#define XB_SPIN(cond, bar) do { unsigned _sp = 0; while (cond) { __builtin_amdgcn_s_sleep(1); \
    if ((++_sp & 255u) == 0u) { if (xb_ld(&(bar)[XB_TMO])) break; if (_sp > XB_SPIN_CAP) { atomicAdd(&(bar)[XB_TMO], 1u); break; } } } } while (0)
struct XcdBarrier { unsigned* bar; unsigned x; volatile LAS unsigned* st; bool leader; };
__device__ __forceinline__ XcdBarrier xcd_barrier_post(unsigned* bar, volatile LAS unsigned* st) {
    XcdBarrier b; b.bar = bar; b.x = xb_xcc_id(); b.st = st; b.leader = threadIdx.x == 0;
    if (b.leader) (void)xb_add(&bar[XB_XCNT(b.x)], 1u);
    return b;
}
__device__ __forceinline__ void xcd_barrier_complete(unsigned* bar, unsigned x, unsigned& nloc, unsigned& nx) {
    const unsigned G = gridDim.x * gridDim.y * gridDim.z;
    unsigned sum, cnt, mine, sp = 0u;
    for (;;) {
        sum = 0u; cnt = 0u; mine = 0u;
#pragma unroll
        for (unsigned j = 0; j < 16; ++j) { const unsigned c = xb_ld(&bar[XB_XCNT(j)]); sum += c; cnt += (c > 0u) ? 1u : 0u; mine = (j == x) ? c : mine; }
        if (sum == G) break;
        __builtin_amdgcn_s_sleep(1);
        if ((++sp & 255u) == 0u) { if (xb_ld(&bar[XB_TMO])) break; if (sp > XB_SPIN_CAP) { atomicAdd(&bar[XB_TMO], 1u); break; } }
    }
    nloc = mine > 0u ? mine : 1u; nx = cnt > 0u ? cnt : 1u;
}
__device__ __forceinline__ void xcd_barrier(const XcdBarrier& b) {
    asm volatile("s_waitcnt vmcnt(0)" ::: "memory");
    __syncthreads();
    if (b.leader) {
        unsigned* bar = b.bar;
        __builtin_amdgcn_s_waitcnt(0);
        unsigned nloc = b.st[0], nx = b.st[1];
        if (nloc == 0u) { xcd_barrier_complete(bar, b.x, nloc, nx); b.st[0] = nloc; b.st[1] = nx; }
        const unsigned old = xb_add(&bar[XB_XSUB(b.x)], 1u);
        const unsigned gen = old / nloc;
        if (old + 1u == (gen + 1u) * nloc) {
            __builtin_amdgcn_fence(__ATOMIC_RELEASE, "agent");
            asm volatile("s_waitcnt vmcnt(0)" ::: "memory");
            const unsigned og = xb_add(&bar[XB_TOP], 1u);
            const unsigned tg = og / nx;
            if (og + 1u == (tg + 1u) * nx) xb_add(&bar[XB_TOPGEN], 1u);
            else XB_SPIN(xb_ld(&bar[XB_TOPGEN]) == tg, bar);
            __builtin_amdgcn_fence(__ATOMIC_ACQUIRE, "agent");
            xb_add(&bar[XB_XGEN(b.x)], 1u);
            asm volatile("s_waitcnt vmcnt(0)" ::: "memory");
        } else {
            XB_SPIN(xb_ld(&bar[XB_XGEN(b.x)]) == gen, bar);
            __builtin_amdgcn_fence(__ATOMIC_ACQUIRE, "agent");
            asm volatile("s_waitcnt vmcnt(0)" ::: "memory");
        }
    }
    __syncthreads();
}

__device__ __forceinline__ float shfl_xor_f(float v, int o, int lane) { return __int_as_float(__builtin_amdgcn_ds_bpermute((lane ^ o) << 2, __float_as_int(v))); }
__device__ __forceinline__ float wave_sum(float v, int lane) {
#pragma unroll
    for (int o = 1; o < 64; o <<= 1) v += shfl_xor_f(v, o, lane);
    return v;
}
template <int MODE> __device__ __forceinline__ int wmap(int c) {
    if (MODE == 1) return 256 * (c >> 7) + (c & 127);
    if (MODE == 2) return 256 * (c >> 7) + 128 + (c & 127);
    if (MODE == 3) { const int h = c / 192, w = c % 192; if (w < 128) return c; int j = w - 128;
        if (j < 32) return h * 192 + 128 + 8 * (j >> 2) + (j & 3); j -= 32; return h * 192 + 128 + 8 * (j >> 2) + 4 + (j & 3); }
    if (MODE == 4) { if (c < QLR + KVL) return c; int j = c - (QLR + KVL);
        if (j < 32) return QLR + KVL + 8 * (j >> 2) + (j & 3); j -= 32; return QLR + KVL + 8 * (j >> 2) + 4 + (j & 3); }
    return c;
}
template <int MODE> __device__ __forceinline__ void tr_item(const float* __restrict__ W, int N, bf16_t* __restrict__ WT, int Kd, LAS float* scr, int item, int lane, const float* __restrict__ gk = nullptr) {
    const int nblk = N / 32, kb = item / nblk, nb = item % nblk, k0 = 64 * kb, n0 = 32 * nb;
    const int c = lane & 7;
    f32x4 g0 = {1.f, 1.f, 1.f, 1.f}, g1 = {1.f, 1.f, 1.f, 1.f};
    if (gk) { g0 = *(const f32x4*)(gk + k0 + 8 * c); g1 = *(const f32x4*)(gk + k0 + 8 * c + 4); }
    float wv[32];
#pragma unroll
    for (int i = 0; i < 32; ++i) { const int kk = 2 * i + (lane >> 5); wv[i] = W[(size_t)(k0 + kk) * N + n0 + (lane & 31)]; }
#pragma unroll
    for (int i = 0; i < 32; ++i) { const int kk = 2 * i + (lane >> 5); scr[kk * 33 + (lane & 31)] = wv[i]; }
    LDS_WAIT(); asm volatile("" ::: "memory");
#pragma unroll
    for (int j = 0; j < 4; ++j) { const int n = (lane >> 3) + 8 * j; const LAS float* s = scr + (8 * c) * 33 + n;
        u32x4 o; o.x = pk2(s[0 * 33] * g0.x, s[1 * 33] * g0.y); o.y = pk2(s[2 * 33] * g0.z, s[3 * 33] * g0.w); o.z = pk2(s[4 * 33] * g1.x, s[5 * 33] * g1.y); o.w = pk2(s[6 * 33] * g1.z, s[7 * 33] * g1.w);
        *(GAS u32x4*)(WT + (size_t)wmap<MODE>(n0 + n) * Kd + k0 + 8 * c) = o; }
    LDS_WAIT(); asm volatile("" ::: "memory");
}
__device__ __forceinline__ void prep_row0(const float* __restrict__ xrow, bf16_t* __restrict__ orow, pg8::u64* __restrict__ ssp, int lane) {
    const GAS f32x4* xr = (const GAS f32x4*)xrow + lane;
    f32x4 v[8]; float s = 0.f;
#pragma unroll
    for (int j = 0; j < 8; ++j) { v[j] = xr[64 * j]; s += (v[j].x * v[j].x + v[j].y * v[j].y) + (v[j].z * v[j].z + v[j].w * v[j].w); }
    s = wave_sum(s, lane);
    if (lane == 0) *ssp = (pg8::u64)(s * pg8::SS_SCALE + 0.5f);
    GAS u32x2* o8 = (GAS u32x2*)orow + lane;
#pragma unroll
    for (int j = 0; j < 8; ++j) { u32x2 w; w.x = cvt_pk_bf16(v[j].x, v[j].y); w.y = cvt_pk_bf16(v[j].z, v[j].w); o8[64 * j] = w; }
}
__device__ __forceinline__ void final_row(const bf16_t* __restrict__ xrow, const float* __restrict__ gain, float* __restrict__ orow, int lane) {
    u32x4 w[4]; float s = 0.f; f32x4 v[4][2];
#pragma unroll
    for (int j = 0; j < 4; ++j) w[j] = *(const GAS u32x4*)(xrow + 8 * lane + 512 * j);
#pragma unroll
    for (int j = 0; j < 4; ++j) { v[j][0] = (f32x4){__uint_as_float(w[j].x << 16), __uint_as_float(w[j].x & 0xffff0000u), __uint_as_float(w[j].y << 16), __uint_as_float(w[j].y & 0xffff0000u)};
        v[j][1] = (f32x4){__uint_as_float(w[j].z << 16), __uint_as_float(w[j].z & 0xffff0000u), __uint_as_float(w[j].w << 16), __uint_as_float(w[j].w & 0xffff0000u)};
#pragma unroll
        for (int h = 0; h < 2; ++h) s += (v[j][h].x * v[j][h].x + v[j][h].y * v[j][h].y) + (v[j][h].z * v[j][h].z + v[j][h].w * v[j][h].w); }
    const float rstd = 1.f / sqrtf(wave_sum(s, lane) * (1.f / DM) + NORM_EPS);
#pragma unroll
    for (int j = 0; j < 4; ++j)
#pragma unroll
        for (int h = 0; h < 2; ++h) { const f32x4 g = *(const f32x4*)(gain + 8 * lane + 512 * j + 4 * h); *(GAS f32x4*)(orow + 8 * lane + 512 * j + 4 * h) = (v[j][h] * rstd) * g; }
}
__device__ __forceinline__ void sincos_d(double x, double& s, double& c) {
    const double q = __builtin_rint(x * 0.63661977236758134308);
    double y = __builtin_fma(-q, 1.57079632679489655800e+00, x); y = __builtin_fma(-q, 6.12323399573676603587e-17, y);
    const int qi = (int)q; const double y2 = y * y;
    const double sp = y * (1.0 + y2 * (-1.0 / 6.0 + y2 * (1.0 / 120.0 + y2 * (-1.0 / 5040.0 + y2 * (1.0 / 362880.0 + y2 * (-1.0 / 39916800.0 + y2 * (1.0 / 6227020800.0 + y2 * (-1.0 / 1307674368000.0))))))));
    const double cp = 1.0 + y2 * (-0.5 + y2 * (1.0 / 24.0 + y2 * (-1.0 / 720.0 + y2 * (1.0 / 40320.0 + y2 * (-1.0 / 3628800.0 + y2 * (1.0 / 479001600.0 + y2 * (-1.0 / 87178291200.0 + y2 * (1.0 / 20922789888000.0))))))));
    const int k = qi & 3;
    s = (k == 0) ? sp : (k == 1) ? cp : (k == 2) ? -sp : -cp;
    c = (k == 0) ? cp : (k == 1) ? -sp : (k == 2) ? -cp : sp;
}
__device__ __forceinline__ double inv_freq(int j) {
    const int a = j >> 3, b = j & 7;
    const double pa = (a == 0) ? 1.0 : (a == 1) ? 0.1 : (a == 2) ? 0.01 : 0.001;
    const double pb = (b == 0) ? 1.0 : (b == 1) ? 0.7498942093324559 : (b == 2) ? 0.5623413251903491 : (b == 3) ? 0.4216965034285822 : (b == 4) ? 0.31622776601683794
                    : (b == 5) ? 0.23713737056616552 : (b == 6) ? 0.1778279410038923 : 0.1333521432163324;
    return pa * pb;
}

struct Args { const float* in[16]; float* out; unsigned char* ws; };
typedef const __attribute__((address_space(4))) Args* KArgs;
__device__ __forceinline__ KArgs kargs() { auto p = __builtin_amdgcn_kernarg_segment_ptr(); asm volatile("" : "+s"(p)); return (KArgs)p; }
#define KA_IN(i) (kargs()->in[i])
#define KA_WS() (kargs()->ws)
#define KA_OUT() (kargs()->out)
__global__ void __launch_bounds__(NWAVES * 64, 2) fwd(Args args) {
    (void)args;
    extern __shared__ __attribute__((aligned(16))) unsigned char lds[];
    LAS unsigned char* const ldsl = (LAS unsigned char*)lds;
    const int wave0 = __builtin_amdgcn_readfirstlane(threadIdx.x >> 6);
    constexpr int G = NBLK; const int bx = blockIdx.x, vcu = (bx % 8) * (G / 8) + bx / 8;
    constexpr int NGW = G * NWAVES, NGT = G * NWAVES * 64;
#define IDS() int wave_ = wave0; asm volatile("" : "+s"(wave_)); const int lane = fresh_lane(), wave = wave_, tid = wave * 64 + lane; const int gw = vcu * NWAVES + wave, gt = vcu * (NWAVES * 64) + tid; (void)lane; (void)gw; (void)gt; (void)tid
    { IDS(); for (int u = tid; u < (LDS_BYTES - LDSCTL_OFF) / 4; u += NWAVES * 64) ((LAS unsigned*)(ldsl + LDSCTL_OFF))[u] = 0u; }
    __syncthreads();
    XcdBarrier bar0 = xcd_barrier_post((unsigned*)(KA_WS() + WS_CTL) + CW_BAR, (volatile LAS unsigned*)(ldsl + MISC_OFF) + 8);
    const unsigned bar_x = bar0.x;
    if (PROBE_CLASS != 0 && bx == 0 && wave0 == 0 && fresh_lane() == 0) { volatile LAS unsigned long long* pt_ = (volatile LAS unsigned long long*)(ldsl + MISC_OFF + 64); pt_[0] = __builtin_amdgcn_s_memrealtime(); pt_[1] = 0ull; }
#define GRID_BAR(label) do { XcdBarrier b_; b_.bar = (unsigned*)(KA_WS() + WS_CTL) + CW_BAR; b_.x = bar_x; b_.st = (volatile LAS unsigned*)(ldsl + MISC_OFF) + 8; b_.leader = (wave0 == 0) && (fresh_lane() == 0); \
        if (PROBE_CLASS != 0 && PROBE_MODE == 1) { __syncthreads(); if (bx == 0 && b_.leader) { volatile LAS unsigned long long* pt_ = (volatile LAS unsigned long long*)(ldsl + MISC_OFF + 64); pt_[0] = __builtin_amdgcn_s_memrealtime(); } } \
        xcd_barrier(b_); \
        if (PROBE_CLASS != 0 && bx == 0 && b_.leader) { volatile LAS unsigned long long* pt_ = (volatile LAS unsigned long long*)(ldsl + MISC_OFF + 64); const unsigned long long now_ = __builtin_amdgcn_s_memrealtime(); \
            if ((label) == PROBE_CLASS) pt_[1] += now_ - pt_[0]; pt_[0] = now_; } } while (0)
#define SCR() ((LAS float*)(ldsl + RING_OFF + wave * 16384))

    { IDS(); unsigned char* const ws = KA_WS(); float* const tabc = (float*)(ws + WS_ROPE_C); float* const tabs = (float*)(ws + WS_ROPE_S);
      for (int e = gt; e < SEQ_P * 32; e += NGT) { const int pos = e >> 5, j = e & 31; double s, c; sincos_d((double)pos * inv_freq(j), s, c); tabc[e] = (float)c; tabs[e] = (float)s; } }

    for (int layer = 0; layer < 4; ++layer) {
        const int lj = layer >> 1; const bool isB = (layer & 1) != 0;
        for (int rep = 0; rep < REP_THIN; ++rep)
        {
            constexpr int I_G = (DM / 64) * (DFF / 32), I_D = (DFF / 64) * (DM / 32), I_O = (DM / 64) * (DM / 32);
            if (!isB) {
                constexpr int I_QKV = (DM / 64) * (NQKV / 32);
                { IDS(); unsigned char* const ws = KA_WS(); const float* wqkv = KA_IN(5) + (size_t)lj * DM * NQKV;
                  const float* gmix = KA_IN(2) + layer * DM;
                  for (int it = gw; it < I_QKV; it += NGW) tr_item<0>(wqkv, NQKV, (bf16_t*)(ws + W_QKV), DM, SCR(), it, lane, gmix); }
                { IDS(); unsigned char* const ws = KA_WS(); const float* wo = KA_IN(6) + (size_t)lj * DM * DM;
                  for (int it = gw; it < I_O; it += NGW) tr_item<0>(wo, DM, (bf16_t*)(ws + W_O), DM, SCR(), it, lane); }
            } else {
                constexpr int I_A = (DM / 64) * (NA / 32), I_UQ = (QLR / 64) * (NQ / 32), I_UKV = (KVL / 64) * (NKV / 32);
                { IDS(); unsigned char* const ws = KA_WS(); const float* wa = KA_IN(7) + (size_t)lj * DM * NA;
                  const float* gmix = KA_IN(2) + layer * DM;
                  for (int it = gw; it < I_A; it += NGW) tr_item<4>(wa, NA, (bf16_t*)(ws + W_WA), DM, SCR(), it, lane, gmix);
                  pg8::u64* const lss = (pg8::u64*)(ws + WS_SS) + (size_t)(2 * layer - 2) * T_ALL; unsigned zq = 0u; asm volatile("" : "+v"(zq)); for (int e = gt; e < 2 * T_ALL; e += NGT) *(GAS u32x2*)(lss + e) = (u32x2){zq, zq}; }
                { IDS(); unsigned char* const ws = KA_WS(); const float* wuq = KA_IN(10) + (size_t)lj * QLR * NQ;
                  for (int it = gw; it < I_UQ; it += NGW) tr_item<3>(wuq, NQ, (bf16_t*)(ws + W_UQ), QLP, SCR(), it, lane, KA_IN(8) + lj * QLR);
                  unsigned zz = 0u; asm volatile("" : "+v"(zz));
                  for (int e = gt; e < NQ * 8; e += NGT) *(GAS u32x4*)((bf16_t*)(ws + W_UQ) + (size_t)(e >> 3) * QLP + QLR + (e & 7) * 8) = (u32x4){zz, zz, zz, zz}; }
                { IDS(); unsigned char* const ws = KA_WS(); const float* wukv = KA_IN(11) + (size_t)lj * KVL * NKV;
                  for (int it = gw; it < I_UKV; it += NGW) tr_item<0>(wukv, NKV, (bf16_t*)(ws + W_UKV), KVL, SCR(), it, lane, KA_IN(9) + lj * KVL); }
                { IDS(); unsigned char* const ws = KA_WS(); const float* wo = KA_IN(12) + (size_t)lj * DM * DM;
                  for (int it = gw; it < I_O; it += NGW) tr_item<0>(wo, DM, (bf16_t*)(ws + W_O), DM, SCR(), it, lane); }
            }
            { IDS(); unsigned char* const ws = KA_WS(); const float* wg = KA_IN(13) + (size_t)layer * DM * DFF;
              const float* gffn = KA_IN(3) + layer * DM;
              for (int it = gw; it < I_G; it += NGW) tr_item<1>(wg, DFF, (bf16_t*)(ws + W_GU), DM, SCR(), it, lane, gffn); }
            { IDS(); unsigned char* const ws = KA_WS(); const float* wu = KA_IN(14) + (size_t)layer * DM * DFF;
              const float* gffn = KA_IN(3) + layer * DM;
              for (int it = gw; it < I_G; it += NGW) tr_item<2>(wu, DFF, (bf16_t*)(ws + W_GU), DM, SCR(), it, lane, gffn); }
            { IDS(); unsigned char* const ws = KA_WS(); const float* wd = KA_IN(15) + (size_t)layer * DFF * DM;
              for (int it = gw; it < I_D; it += NGW) tr_item<0>(wd, DM, (bf16_t*)(ws + W_DN), DFF, SCR(), it, lane); }
            if (layer == 0) { IDS(); unsigned char* const ws = KA_WS(); bf16_t* const Hb = (bf16_t*)(ws + WS_H); pg8::u64* const ss0 = (pg8::u64*)(ws + WS_SS);
              const float* x_prompt = KA_IN(0); const float* x_sample = KA_IN(1);
              for (int m = gw; m < T_ALL; m += NGW) { const float* src = m < T_PROMPT ? x_prompt + (size_t)m * DM : x_sample + (size_t)(m - T_PROMPT) * DM; prep_row0(src, Hb + (size_t)m * DM, ss0 + m, lane); } }
        }
        GRID_BAR(PC_PREP);
        if (!isB) {
            for (int ch = 0; ch < NCHUNK; ++ch) {
                for (int rep = 0; rep < REP_QKV; ++rep)
                { IDS(); unsigned char* const ws = KA_WS();
                  pg8::Gemm g{(const bf16_t*)(ws + WS_H) + (size_t)ch * CHUNK * DM, (const bf16_t*)(ws + W_QKV), CHUNK, NQKV, DM}; pg8::StaticOrder S; S.init(CHUNK, NQKV, G, bx);
                  pg8::EpiBf16 E{(bf16_t*)(ws + S_QKV), NQKV, CHUNK, (const pg8::u64*)(ws + WS_SS) + (size_t)(2 * layer) * T_ALL + (size_t)ch * CHUNK}; pg8::gemm_phase<pg8::EpiBf16, pg8::StaticOrder>(ldsl + RING_OFF, g, S, E, wave0); }
                GRID_BAR(PC_QKV);
                { IDS(); unsigned char* const ws = KA_WS(); const bf16_t* const QKV = (const bf16_t*)(ws + S_QKV); bf16_t* const OG = (bf16_t*)(ws + S_OG); float* const LSE = (float*)(ws + S_LSE);
                  const int S_len = ch < 4 ? SEQ_P : SEQ_S, nseq = ch < 4 ? 1 : 2, NB = S_len / 64;
                  const int L2 = (NB / 16) < 8 ? (NB / 16) : 8, c01 = NH * (NB / 8), c2 = NH * (NB / L2), per_seq = 2 * c01 + c2, nitems = nseq * per_seq;
                  for (int rep = 0; rep < REP_DWA; ++rep)
                  for (int it = vcu; it < nitems; it += G) {
                      const int ir = nitems - 1 - it;
                      const int sq = ir / per_seq, r0 = ir % per_seq, g = r0 < c01 ? 0 : (r0 < 2 * c01 ? 1 : 2), r1 = r0 - g * c01;
                      const int dil = g == 0 ? 1 : (g == 1 ? 4 : 16), L = g == 2 ? L2 : 8, per_h = NB / L, h = r1 / per_h, j = r1 % per_h, per_c = (NB / dil) / L;
                      dwa::item(QKV, OG, LSE, sq * S_len, S_len, g, dil, j / per_c, (j % per_c) * L, L, h, (char*)lds + RING_OFF, wave0); } }
                GRID_BAR(PC_DWA);
                for (int rep = 0; rep < REP_THIN; ++rep)
                { IDS(); unsigned char* const ws = KA_WS(); const bf16_t* const OG = (const bf16_t*)(ws + S_OG); const float* const LSE = (const float*)(ws + S_LSE); bf16_t* const OA = (bf16_t*)(ws + S_OA);
                  for (int e = gt; e < CHUNK * (DM / 8); e += NGT) { const int row = e >> 8, c8 = e & 255, h = c8 >> 4;
                    const float l0 = LSE[(row * 3 + 0) * NH + h], l1 = LSE[(row * 3 + 1) * NH + h], l2 = LSE[(row * 3 + 2) * NH + h];
                    const float mx = fmaxf(l0, fmaxf(l1, l2)); float w0 = __builtin_amdgcn_exp2f(l0 - mx), w1 = __builtin_amdgcn_exp2f(l1 - mx), w2 = __builtin_amdgcn_exp2f(l2 - mx);
                    const float inv = 1.f / (w0 + w1 + w2); w0 *= inv; w1 *= inv; w2 *= inv;
                    const u32x4 a0 = *(const u32x4*)(OG + ((size_t)row * 3 + 0) * DM + c8 * 8), a1 = *(const u32x4*)(OG + ((size_t)row * 3 + 1) * DM + c8 * 8), a2 = *(const u32x4*)(OG + ((size_t)row * 3 + 2) * DM + c8 * 8);
                    u32x4 o;
#pragma unroll
                    for (int k = 0; k < 4; ++k) { const float lo = w0 * __uint_as_float(a0[k] << 16) + w1 * __uint_as_float(a1[k] << 16) + w2 * __uint_as_float(a2[k] << 16);
                        const float hi = w0 * __uint_as_float(a0[k] & 0xffff0000u) + w1 * __uint_as_float(a1[k] & 0xffff0000u) + w2 * __uint_as_float(a2[k] & 0xffff0000u); o[k] = cvt_pk_bf16(lo, hi); }
                    *(u32x4*)(OA + ((size_t)ch * CHUNK + row) * DM + c8 * 8) = o; } }
                if (PROBE_CLASS != 0 && ch + 1 < NCHUNK) GRID_BAR(PC_MERGE);
            }
        } else {
            { IDS(); unsigned char* const ws = KA_WS();
              pg8::Gemm g{(const bf16_t*)(ws + WS_H), (const bf16_t*)(ws + W_WA), T_ALL, NA, DM}; pg8::StaticOrder S; S.init(T_ALL, NA, G, bx);
              pg8::u64* const lss = (pg8::u64*)(ws + WS_SS) + (size_t)(2 * layer - 2) * T_ALL;
              pg8::EpiLat E{(bf16_t*)(ws + S_CQ), (bf16_t*)(ws + S_CKV), (bf16_t*)(ws + S_KR), (const pg8::u64*)(ws + WS_SS) + (size_t)(2 * layer) * T_ALL, lss, lss + T_ALL, (const float*)(ws + WS_ROPE_C), (const float*)(ws + WS_ROPE_S)};
              pg8::gemm_phase<pg8::EpiLat, pg8::StaticOrder>(ldsl + RING_OFF, g, S, E, wave0); }
            GRID_BAR(PC_WA);
            { IDS(); unsigned char* const ws = KA_WS();
              pg8::Gemm g{(const bf16_t*)(ws + S_CQ), (const bf16_t*)(ws + W_UQ), T_ALL, NQ, QLP}; pg8::StaticOrder S; S.init(T_ALL, NQ, G, bx);
              pg8::EpiQRope E{(bf16_t*)(ws + S_Q), NQ, (const float*)(ws + WS_ROPE_C), (const float*)(ws + WS_ROPE_S), 0, (const pg8::u64*)(ws + WS_SS) + (size_t)(2 * layer - 2) * T_ALL, 1.0f / QLR}; pg8::gemm_phase<pg8::EpiQRope, pg8::StaticOrder>(ldsl + RING_OFF, g, S, E, wave0); }
            { IDS(); unsigned char* const ws = KA_WS();
              pg8::Gemm g{(const bf16_t*)(ws + S_CKV), (const bf16_t*)(ws + W_UKV), T_ALL, NKV, KVL}; pg8::StaticOrder S; S.init(T_ALL, NKV, G, bx);
              pg8::EpiBf16 E{(bf16_t*)(ws + S_KV), NKV, 0, (const pg8::u64*)(ws + WS_SS) + (size_t)(2 * layer - 1) * T_ALL, 1.0f / KVL}; pg8::gemm_phase<pg8::EpiBf16, pg8::StaticOrder>(ldsl + RING_OFF, g, S, E, wave0); }
            GRID_BAR(PC_QKVB);
            {
                IDS(); unsigned char* const ws = KA_WS(); const bf16_t* const Qb = (const bf16_t*)(ws + S_Q); const bf16_t* const KVb = (const bf16_t*)(ws + S_KV); const bf16_t* const KR = (const bf16_t*)(ws + S_KR); bf16_t* const Ob = (bf16_t*)(ws + S_OB);
                for (int rep = 0; rep < REP_MLA; ++rep)
                for (int id = vcu; id < 2560; id += G) {
                    int seqrow0, seqlen, h, qb;
                    if (id < 2048) { const int pair = id >> 5; qb = id & 31; h = pair & 15; seqrow0 = (pair >> 4) * SEQ_P; seqlen = SEQ_P; }
                    else { const int i2 = id - 2048, pair = i2 >> 4; qb = i2 & 15; h = pair & 15; seqrow0 = T_PROMPT + (pair >> 4) * SEQ_S; seqlen = SEQ_S; }
                    mla::attn_unit(Qb + (size_t)(seqrow0 + qb * 256) * NQ + h * 192, KVb + (size_t)seqrow0 * NKV + h * 256, KR + (size_t)seqrow0 * 64, KVb + (size_t)seqrow0 * NKV + h * 256 + 128,
                                   Ob + (size_t)(seqrow0 + qb * 256) * DM + h * 128, seqlen, (char*)lds + RING_OFF, wave0); }
            }
        }
        GRID_BAR((isB ? PC_MLA : PC_MERGE));
        { IDS(); unsigned char* const ws = KA_WS();
          pg8::Gemm g{(const bf16_t*)(ws + (isB ? S_OB : S_OA)), (const bf16_t*)(ws + W_O), T_ALL, DM, DM}; pg8::StaticOrder S; S.init(T_ALL, DM, G, bx);
          pg8::EpiRes E{(bf16_t*)(ws + WS_H), DM, (pg8::u64*)(ws + WS_SS) + (size_t)(2 * layer + 1) * T_ALL};
          pg8::gemm_phase<pg8::EpiRes, pg8::StaticOrder, true, false>(ldsl + RING_OFF, g, S, E, wave0); }
        GRID_BAR(PC_WO);
        for (int rep = 0; rep < REP_FFN; ++rep)
        { IDS(); unsigned char* const ws = KA_WS();
          pg8::Gemm g{(const bf16_t*)(ws + WS_H), (const bf16_t*)(ws + W_GU), T_ALL, 2 * DFF, DM}; pg8::StaticOrder S; S.init(T_ALL, 2 * DFF, G, bx);
          pg8::EpiSwiGLU E{(bf16_t*)(ws + S_ACT), DFF, (const pg8::u64*)(ws + WS_SS) + (size_t)(2 * layer + 1) * T_ALL}; pg8::gemm_phase<pg8::EpiSwiGLU, pg8::StaticOrder>(ldsl + RING_OFF, g, S, E, wave0); }
        GRID_BAR(PC_GU);
        { IDS(); unsigned char* const ws = KA_WS();
          pg8::Gemm g{(const bf16_t*)(ws + S_ACT), (const bf16_t*)(ws + W_DN), T_ALL, DM, DFF}; pg8::StaticOrder S; S.init(T_ALL, DM, G, bx);
          pg8::EpiRes E{(bf16_t*)(ws + WS_H), DM, layer < 3 ? (pg8::u64*)(ws + WS_SS) + (size_t)(2 * layer + 2) * T_ALL : nullptr};
          pg8::gemm_phase<pg8::EpiRes, pg8::StaticOrder, true, false>(ldsl + RING_OFF, g, S, E, wave0); }
        GRID_BAR(PC_DOWN);
    }
    { IDS(); float* const out = KA_OUT(); const float* norm_final = KA_IN(4); const bf16_t* const Hb = (const bf16_t*)(KA_WS() + WS_H);
      const unsigned dead = __hip_atomic_load((unsigned*)(KA_WS() + WS_CTL) + CW_BAR + XB_TMO, RLX_AGENT);
      for (int m = gw; m < T_ALL; m += NGW) { final_row(Hb + (size_t)m * DM, norm_final, out + (size_t)m * DM, lane);
          if (dead) { const float qn = __builtin_nanf(""); ((GAS f32x4*)(out + (size_t)m * DM))[lane] = (f32x4){qn, qn, qn, qn}; } } }
    if (PROBE_CLASS != 0 && bx == 0 && wave0 == 0 && fresh_lane() == 0) {
        volatile LAS unsigned long long* pt_ = (volatile LAS unsigned long long*)(ldsl + MISC_OFF + 64); const unsigned long long t0_ = __builtin_amdgcn_s_memrealtime(), wait_ = (unsigned long long)PROBE_AMP * pt_[1];
        while (__builtin_amdgcn_s_memrealtime() - t0_ < wait_) __builtin_amdgcn_s_sleep(32); }
}

extern "C" void kernel_launch(void* const* d_in, const int* in_sizes, int n_in, void* d_out, int out_size, void* d_ws, size_t ws_size, hipStream_t stream) {
    static int grid = 0;
    if (grid == 0) {
        if (n_in != 16 || out_size != T_ALL * DM || ws_size < WS_END) { fprintf(stderr, "kernel_launch: shape mismatch (n_in %d out %d ws %zu, need ws >= %zu)\n", n_in, out_size, ws_size, (size_t)WS_END); grid = -1; return; }
        int dev = 0, cus = 0, per_cu = 0;
        if (hipGetDevice(&dev) != hipSuccess || hipDeviceGetAttribute(&cus, hipDeviceAttributeMultiprocessorCount, dev) != hipSuccess) { grid = -1; return; }
        if (hipFuncSetAttribute((const void*)fwd, hipFuncAttributeMaxDynamicSharedMemorySize, LDS_BYTES) != hipSuccess) { fprintf(stderr, "kernel_launch: hipFuncSetAttribute failed\n"); grid = -1; return; }
        if (hipOccupancyMaxActiveBlocksPerMultiprocessor(&per_cu, (const void*)fwd, NWAVES * 64, LDS_BYTES) != hipSuccess || per_cu < 1)
            fprintf(stderr, "kernel_launch: occupancy query reports %d workgroups per CU\n", per_cu);
        (void)hipGetLastError();
        if (cus < NBLK) { fprintf(stderr, "kernel_launch: built for %d CUs, device has %d\n", NBLK, cus); grid = -1; return; }
        grid = NBLK;
    }
    if (grid < 0) return;
    if (hipMemsetAsync((char*)d_ws + WS_CTL, 0, CTL_ZERO_BYTES, stream) != hipSuccess) { fprintf(stderr, "kernel_launch: memset failed\n"); return; }
    Args a{};
    for (int i = 0; i < 16; ++i) a.in[i] = (const float*)d_in[i];
    a.out = (float*)d_out; a.ws = (unsigned char*)d_ws;
    hipLaunchKernelGGL(fwd, dim3(grid), dim3(NWAVES * 64), LDS_BYTES, stream, a);
    const hipError_t le = hipPeekAtLastError();
    if (le != hipSuccess) fprintf(stderr, "kernel_launch: launch failed: %s\n", hipGetErrorName(le));
}
```

```cpp
#include <hip/hip_runtime.h>
#include <cstdio>
#include <cstdint>
#ifndef PROBE_CLASS
#define PROBE_CLASS 0
#endif
#define PROBE_AMP 8
#ifndef PROBE_MODE
#define PROBE_MODE 0
#endif
enum { PC_NONE = 0, PC_PREP = 1, PC_QKV = 2, PC_DWA = 3, PC_MERGE = 4, PC_WA = 5, PC_ANORM = 6, PC_QKVB = 7, PC_MLA = 8, PC_WO = 9, PC_GU = 10, PC_DOWN = 11 };
#ifndef REP_FFN
#define REP_FFN 1
#endif
#ifndef REP_MLA
#define REP_MLA 1
#endif
#ifndef REP_THIN
#define REP_THIN 1
#endif
#ifndef REP_DWA
#define REP_DWA 1
#endif
#ifndef REP_QKV
#define REP_QKV 1
#endif

#define LAS __attribute__((address_space(3)))
#define GAS __attribute__((address_space(1)))
typedef unsigned short bf16_t;
typedef short bf16x8 __attribute__((ext_vector_type(8)));
typedef short s16x4 __attribute__((ext_vector_type(4)));
typedef float f32x4 __attribute__((ext_vector_type(4)));
typedef float f32x2 __attribute__((ext_vector_type(2)));
typedef float f32x16 __attribute__((ext_vector_type(16)));
typedef unsigned u32x4 __attribute__((ext_vector_type(4)));
typedef unsigned u32x2 __attribute__((ext_vector_type(2)));
typedef GAS unsigned gu32;

constexpr int DM = 2048, T_ALL = 40960, T_PROMPT = 32768, SEQ_P = 8192, SEQ_S = 4096;
constexpr int DFF = 5632, NQKV = 18432, NA = 1024, QLR = 448, QLP = 512, KVL = 512, NQ = 3072, NKV = 4096, NH = 16;
constexpr int CHUNK = 8192, NCHUNK = 5;
constexpr float NORM_EPS = 1e-6f;
constexpr float LOG2E = 1.4426950408889634f;

__device__ __forceinline__ int fresh_lane() { int l; asm volatile("v_mbcnt_lo_u32_b32 %0, -1, 0\n\tv_mbcnt_hi_u32_b32 %0, -1, %0" : "=v"(l)); return l; }
__device__ __forceinline__ unsigned cvt_pk_bf16(float lo, float hi) { unsigned r; asm volatile("v_cvt_pk_bf16_f32 %0, %1, %2" : "=v"(r) : "v"(lo), "v"(hi)); return r; }
__device__ __forceinline__ int row_pos(int row) { return row < T_PROMPT ? (row & (SEQ_P - 1)) : (row & (SEQ_S - 1)); }

namespace pg8 {
constexpr int BM = 256, BK = 64, HALF = 128, HTB = HALF * BK * 2, STAGE_BYTES = 8 * HTB, NXCD = 8, WGM = 8;
__host__ __device__ __forceinline__ int lds_byte(int r, int c) { const int st = (r >> 4) * 2 + (c >> 5), rr = r & 15, cc = c & 31, ob = rr * 64 + cc * 2; return st * 1024 + (ob ^ (((ob >> 9) & 1) << 5)); }
__host__ __device__ __forceinline__ void stage_rc(int b, int& R, int& C) { const int st = b / 1024, sb = b % 1024, swz = sb ^ (((sb >> 9) & 1) << 5); R = (st >> 1) * 16 + swz / 64; C = (st & 1) * 32 + (swz % 64) / 2; }
__host__ __device__ __forceinline__ int perm32(int rho) { const int n = rho >> 4, i = rho & 15; return 8 * (i >> 2) + 4 * n + (i & 3); }

struct Unit { int pm, pn; };
struct Gemm { const bf16_t* A; const bf16_t* Bt; int M, N, K; };

struct StaticOrder {
    int nM, nN, nwg, G, c;
    __host__ __device__ void init(int M, int N, int G_, int c_) { nM = M / BM; nN = N / BM; nwg = nM * nN; G = G_; c = c_; }
    __host__ __device__ bool next(int i, Unit& u) const {
        const long L = (long)i * G + c; if (L >= nwg) return false;
        int wgid = (int)L; { const int q = nwg / NXCD, r = nwg % NXCD, xcd = wgid % NXCD, off = wgid / NXCD; wgid = (xcd < r ? xcd * (q + 1) : r * (q + 1) + (xcd - r) * q) + off; }
        const int nig = WGM * nN, gid = wgid / nig, fm = gid * WGM, gsz = (nM - fm) < WGM ? (nM - fm) : WGM;
        u.pm = fm + ((wgid % nig) % gsz); u.pn = (wgid % nig) / gsz; return true;
    }
    __device__ __forceinline__ void a_ready(const Unit&) const {}
    __device__ __forceinline__ void done(const Unit&) const {}
};

typedef unsigned long long u64;
constexpr float SS_SCALE = 1048576.0f, SS_INV = 1.0f / 1048576.0f;
__device__ __forceinline__ float u64_to_f32(unsigned lo, unsigned hi) { return fmaf((float)hi, 4294967296.0f, (float)lo); }
__device__ __forceinline__ u64 f32_to_u64(float qs) {
    const unsigned hi = (unsigned)(qs * (1.0f / 4294967296.0f)); const unsigned lo = (unsigned)fmaf(-(float)hi, 4294967296.0f, qs); return ((u64)hi << 32) | lo; }
__device__ __forceinline__ float row_rstd(const u64* ss, int row) { return ss ? __builtin_amdgcn_rsqf((float)ss[row] * (SS_INV / DM) + NORM_EPS) : 1.0f; }
struct PreNone { };
struct PreSS { int off; };
constexpr int SS_LDS = STAGE_BYTES;
__device__ __forceinline__ void prefetch_ss(PreSS& p, const u64* ss, const Unit& u, LAS unsigned char* lds, int ui, int wid, int lane) {
    p.off = SS_LDS + (ui & 1) * 2048;
    if (ss && wid == 0) {
        const u64* src = ss + (size_t)u.pm * BM + lane * 2;
        __builtin_amdgcn_global_load_lds((const unsigned*)src, (LAS unsigned*)(lds + p.off), 16, 0, 0);
        __builtin_amdgcn_global_load_lds((const unsigned*)(src + 128), (LAS unsigned*)(lds + p.off + 1024), 16, 0, 0); }
}
__device__ __forceinline__ float pre_rstd(const PreSS& p, const u64* ss, LAS unsigned char* lds, int rowt, float inv_n = 1.0f / DM) { if (!ss) return 1.0f; const u32x2 w = *(const LAS u32x2*)(lds + p.off + rowt * 8); return __builtin_amdgcn_rsqf(u64_to_f32(w.x, w.y) * (SS_INV * inv_n) + NORM_EPS); }
struct EpiBf16 {
    static constexpr bool PERM = true, AFTER_DRAIN = false; static constexpr bool PEEL = true; static constexpr int NST = 16;
    bf16_t* O; int ldc; int sect_rows; const u64* ss; float inv_n = 1.0f / DM;
    typedef PreSS Pre;
    __device__ __forceinline__ void prefetch(Pre& p, const Unit& u, LAS unsigned char* lds, int ui, int wid, int lane) const { prefetch_ss(p, ss, u, lds, ui, wid, lane); }
    __device__ __forceinline__ void operator()(const f32x4 (&acc)[2][2][4][2], const Unit& u, int wr, int wc, int fr, int fq, const Pre& pre, LAS unsigned char* lds) const {
        const int row0 = u.pm * BM + wr * 64 + fr, col0 = u.pn * BM + wc * 32 + 8 * fq;
#pragma unroll
        for (int ai = 0; ai < 2; ++ai)
#pragma unroll
            for (int m = 0; m < 4; ++m) { const int row = row0 + ai * HALF + m * 16; const float rs = pre_rstd(pre, ss, lds, ai * HALF + wr * 64 + m * 16 + fr, inv_n);
#pragma unroll
                for (int bj = 0; bj < 2; ++bj) { const f32x4 v0 = acc[ai][bj][m][0] * rs, v1 = acc[ai][bj][m][1] * rs;
                    bf16_t* p = sect_rows ? O + ((size_t)(2 * u.pn + bj) * sect_rows + row) * 128 + wc * 32 + 8 * fq : O + (size_t)row * ldc + col0 + bj * HALF;
                    u32x4 w; w.x = cvt_pk_bf16(v0[0], v0[1]); w.y = cvt_pk_bf16(v0[2], v0[3]); w.z = cvt_pk_bf16(v1[0], v1[1]); w.w = cvt_pk_bf16(v1[2], v1[3]);
                    *(u32x4*)p = w; } }
    }
};
struct EpiQRope {
    static constexpr bool PERM = true, AFTER_DRAIN = false; static constexpr bool PEEL = true; static constexpr int NST = 16;
    bf16_t* O; int ldc; const float* tabc; const float* tabs; int row_base; const u64* ss; float inv_n;
    typedef PreSS Pre;
    __device__ __forceinline__ void prefetch(Pre& p, const Unit& u, LAS unsigned char* lds, int ui, int wid, int lane) const { prefetch_ss(p, ss, u, lds, ui, wid, lane); }
    __device__ __forceinline__ void operator()(const f32x4 (&acc)[2][2][4][2], const Unit& u, int wr, int wc, int fr, int fq, const Pre& pre, LAS unsigned char* lds) const {
        const int row0 = u.pm * BM + wr * 64 + fr, col0 = u.pn * BM + wc * 32 + 8 * fq;
#pragma unroll
        for (int bj = 0; bj < 2; ++bj) {
            const int G = u.pn * 8 + bj * 4 + wc, within = G % 6;
            const bool rope = within >= 4; const int j0 = 16 * (within - 4) + 4 * fq;
#pragma unroll
            for (int ai = 0; ai < 2; ++ai)
#pragma unroll
                for (int m = 0; m < 4; ++m) { const int row = row0 + ai * HALF + m * 16; bf16_t* rowp = O + (size_t)row * ldc + col0 + bj * HALF;
                    const float rs = pre_rstd(pre, ss, lds, ai * HALF + wr * 64 + m * 16 + fr, inv_n);
                    f32x4 v0 = acc[ai][bj][m][0] * rs, v1 = acc[ai][bj][m][1] * rs;
                    if (rope) { const int pos = row_pos(row_base + row); const f32x4 c = *(const f32x4*)(tabc + pos * 32 + j0), s = *(const f32x4*)(tabs + pos * 32 + j0);
                        const f32x4 o1 = v0 * c - v1 * s, o2 = v0 * s + v1 * c; v0 = o1; v1 = o2; }
                    u32x4 w; w.x = cvt_pk_bf16(v0[0], v0[1]); w.y = cvt_pk_bf16(v0[2], v0[3]); w.z = cvt_pk_bf16(v1[0], v1[1]); w.w = cvt_pk_bf16(v1[2], v1[3]);
                    *(u32x4*)rowp = w; }
        }
    }
};
struct EpiSwiGLU {
    static constexpr bool PERM = true, AFTER_DRAIN = false; static constexpr bool PEEL = true; static constexpr int NST = 8;
    bf16_t* O; int ldc; const u64* ss;
    typedef PreSS Pre;
    __device__ __forceinline__ void prefetch(Pre& p, const Unit& u, LAS unsigned char* lds, int ui, int wid, int lane) const { prefetch_ss(p, ss, u, lds, ui, wid, lane); }
    __device__ __forceinline__ void operator()(const f32x4 (&acc)[2][2][4][2], const Unit& u, int wr, int wc, int fr, int fq, const Pre& pre, LAS unsigned char* lds) const {
        const int row0 = u.pm * BM + wr * 64 + fr, col0 = u.pn * HALF + wc * 32 + 8 * fq;
#pragma unroll
        for (int ai = 0; ai < 2; ++ai)
#pragma unroll
            for (int m = 0; m < 4; ++m) { const int row = row0 + ai * HALF + m * 16; bf16_t* rowp = O + (size_t)row * ldc + col0; const float rs = pre_rstd(pre, ss, lds, ai * HALF + wr * 64 + m * 16 + fr);
                const float rsl = -rs * LOG2E, rs2 = rs * rs; f32x4 o4[2];
#pragma unroll
                for (int n = 0; n < 2; ++n) { const f32x4 G = acc[ai][0][m][n], U = acc[ai][1][m][n]; const f32x4 T = G * rsl;
                    f32x4 D = (f32x4){__builtin_amdgcn_exp2f(T[0]), __builtin_amdgcn_exp2f(T[1]), __builtin_amdgcn_exp2f(T[2]), __builtin_amdgcn_exp2f(T[3])} + 1.0f;
                    const f32x4 R = (f32x4){__builtin_amdgcn_rcpf(D[0]), __builtin_amdgcn_rcpf(D[1]), __builtin_amdgcn_rcpf(D[2]), __builtin_amdgcn_rcpf(D[3])};
                    o4[n] = (G * U) * (R * rs2); }
                u32x4 w; w.x = cvt_pk_bf16(o4[0][0], o4[0][1]); w.y = cvt_pk_bf16(o4[0][2], o4[0][3]); w.z = cvt_pk_bf16(o4[1][0], o4[1][1]); w.w = cvt_pk_bf16(o4[1][2], o4[1][3]);
                *(u32x4*)rowp = w; }
    }
};
struct EpiRes {
    static constexpr bool PERM = true, AFTER_DRAIN = false; static constexpr bool PEEL = true; static constexpr int NST = 16;
    bf16_t* x; int ldc; u64* ss;
    typedef PreNone Pre;
    __device__ __forceinline__ void prefetch(Pre&, const Unit&, LAS unsigned char*, int, int, int) const {}
    __device__ __forceinline__ void operator()(const f32x4 (&acc)[2][2][4][2], const Unit& u, int wr, int wc, int fr, int fq, const Pre&, LAS unsigned char*) const {
        const int col0 = u.pn * BM + wc * 32 + 8 * fq, lane = fq * 16 + fr;
        u32x4 b[2][4][2];
#pragma unroll
        for (int ai = 0; ai < 2; ++ai)
#pragma unroll
            for (int m = 0; m < 4; ++m) { const bf16_t* rowp = x + (size_t)(u.pm * BM + ai * HALF + wr * 64 + m * 16 + fr) * ldc + col0;
#pragma unroll
                for (int bj = 0; bj < 2; ++bj) b[ai][m][bj] = *(const u32x4*)(rowp + bj * HALF); }
        asm volatile("" ::: "memory");
#pragma unroll
        for (int ai = 0; ai < 2; ++ai)
#pragma unroll
            for (int m = 0; m < 4; ++m) { const int row = u.pm * BM + ai * HALF + wr * 64 + m * 16 + fr; bf16_t* rowp = x + (size_t)row * ldc + col0;
                f32x4 qv = {0.f, 0.f, 0.f, 0.f};
#pragma unroll
                for (int bj = 0; bj < 2; ++bj) { const u32x4 w0 = b[ai][m][bj];
                    const f32x4 x0 = (f32x4){__uint_as_float(w0.x << 16), __uint_as_float(w0.x & 0xffff0000u), __uint_as_float(w0.y << 16), __uint_as_float(w0.y & 0xffff0000u)} + acc[ai][bj][m][0];
                    const f32x4 x1 = (f32x4){__uint_as_float(w0.z << 16), __uint_as_float(w0.z & 0xffff0000u), __uint_as_float(w0.w << 16), __uint_as_float(w0.w & 0xffff0000u)} + acc[ai][bj][m][1];
                    qv = x0 * x0 + qv; qv = x1 * x1 + qv;
                    u32x4 w; w.x = cvt_pk_bf16(x0.x, x0.y); w.y = cvt_pk_bf16(x0.z, x0.w); w.z = cvt_pk_bf16(x1.x, x1.y); w.w = cvt_pk_bf16(x1.z, x1.w);
                    *(u32x4*)(rowp + bj * HALF) = w; }
                if (ss) { float q = (qv.x + qv.y) + (qv.z + qv.w); q += __int_as_float(__builtin_amdgcn_ds_bpermute((lane ^ 16) << 2, __float_as_int(q))); q += __int_as_float(__builtin_amdgcn_ds_bpermute((lane ^ 32) << 2, __float_as_int(q)));
                    if (fq == 0) (void)__hip_atomic_fetch_add(ss + row, f32_to_u64(q * SS_SCALE + 0.5f), __ATOMIC_RELAXED, __HIP_MEMORY_SCOPE_AGENT); } }
    }
};
struct EpiF32 {
    static constexpr bool PERM = false, AFTER_DRAIN = false; static constexpr bool PEEL = true; static constexpr int NST = 32;
    float* out; int ldc; const u64* ss;
    typedef PreSS Pre;
    __device__ __forceinline__ void prefetch(Pre& p, const Unit& u, LAS unsigned char* lds, int ui, int wid, int lane) const { prefetch_ss(p, ss, u, lds, ui, wid, lane); }
    __device__ __forceinline__ void operator()(const f32x4 (&acc)[2][2][4][2], const Unit& u, int wr, int wc, int fr, int fq, const Pre& pre, LAS unsigned char* lds) const {
        const int col0 = u.pn * BM + wc * 32 + 4 * fq;
#pragma unroll
        for (int ai = 0; ai < 2; ++ai)
#pragma unroll
            for (int m = 0; m < 4; ++m) { const int row = u.pm * BM + ai * HALF + wr * 64 + m * 16 + fr; float* rowp = out + (size_t)row * ldc + col0; const float rs = pre_rstd(pre, ss, lds, ai * HALF + wr * 64 + m * 16 + fr);
#pragma unroll
                for (int bj = 0; bj < 2; ++bj)
#pragma unroll
                    for (int n = 0; n < 2; ++n) *(f32x4*)(rowp + bj * HALF + n * 16) = acc[ai][bj][m][n] * rs; }
    }
};

struct EpiLat {
    static constexpr bool PERM = true, AFTER_DRAIN = false; static constexpr bool PEEL = false; static constexpr int NST = 16;
    bf16_t* CQ; bf16_t* CKV; bf16_t* KR; const u64* ss; u64* ssq; u64* sskv; const float* tabc; const float* tabs;
    typedef PreSS Pre;
    __device__ __forceinline__ void prefetch(Pre& p, const Unit& u, LAS unsigned char* lds, int ui, int wid, int lane) const { prefetch_ss(p, ss, u, lds, ui, wid, lane); }
    __device__ __forceinline__ void operator()(const f32x4 (&acc)[2][2][4][2], const Unit& u, int wr, int wc, int fr, int fq, const Pre& pre, LAS unsigned char* lds) const {
        const int lane = fq * 16 + fr;
#pragma unroll
        for (int bj = 0; bj < 2; ++bj) {
            const int cb = u.pn * BM + bj * HALF + wc * 32, col = cb + 8 * fq;
            const int region = cb < QLR ? 0 : (cb < QLR + KVL ? 1 : 2);
#pragma unroll
            for (int ai = 0; ai < 2; ++ai)
#pragma unroll
                for (int m = 0; m < 4; ++m) { const int row = u.pm * BM + ai * HALF + wr * 64 + m * 16 + fr; const float rs = pre_rstd(pre, ss, lds, ai * HALF + wr * 64 + m * 16 + fr);
                    f32x4 v0 = acc[ai][bj][m][0] * rs, v1 = acc[ai][bj][m][1] * rs;
                    if (region == 2) { const int pos = row_pos(row), j0 = (cb - QLR - KVL) / 2 + 4 * fq; const f32x4 c = *(const f32x4*)(tabc + pos * 32 + j0), s = *(const f32x4*)(tabs + pos * 32 + j0);
                        const f32x4 o1 = v0 * c - v1 * s, o2 = v0 * s + v1 * c; v0 = o1; v1 = o2; }
                    u32x4 w; w.x = cvt_pk_bf16(v0[0], v0[1]); w.y = cvt_pk_bf16(v0[2], v0[3]); w.z = cvt_pk_bf16(v1[0], v1[1]); w.w = cvt_pk_bf16(v1[2], v1[3]);
                    if (region == 0) *(u32x4*)(CQ + (size_t)row * QLP + col) = w;
                    else if (region == 1) { *(u32x4*)(CKV + (size_t)row * KVL + (col - QLR)) = w; if (cb < QLP) { unsigned zz = 0u; asm volatile("" : "+v"(zz)); *(u32x4*)(CQ + (size_t)row * QLP + col) = (u32x4){zz, zz, zz, zz}; } }
                    else *(u32x4*)(KR + (size_t)row * 64 + (col - QLR - KVL)) = w;
                    if (region < 2) { float q = ((v0.x * v0.x + v0.y * v0.y) + (v0.z * v0.z + v0.w * v0.w)) + ((v1.x * v1.x + v1.y * v1.y) + (v1.z * v1.z + v1.w * v1.w));
                        q += __int_as_float(__builtin_amdgcn_ds_bpermute((lane ^ 16) << 2, __float_as_int(q))); q += __int_as_float(__builtin_amdgcn_ds_bpermute((lane ^ 32) << 2, __float_as_int(q)));
                        if (fq == 0) (void)__hip_atomic_fetch_add((region == 0 ? ssq : sskv) + row, f32_to_u64(q * SS_SCALE + 0.5f), __ATOMIC_RELAXED, __HIP_MEMORY_SCOPE_AGENT); } }
        }
    }
};

template <class Epi, class Sched, bool ALIGN_EPI = true, bool PEELX = true>
__device__ __forceinline__ void gemm_phase(LAS unsigned char* lds, const Gemm g, const Sched& S, const Epi& E, int wave0) {
    const int lane = fresh_lane(), wid = wave0, tid = wid * 64 + lane;
    const int wr = wid >> 2, wc = wid & 3, fr = lane & 15, fq = lane >> 4;
    const int K = g.K, nt = K / BK;
    unsigned voffA, voffB;
    { int R, C; stage_rc(tid * 16, R, C); const int Rb = Epi::PERM ? ((R & ~31) + perm32(R & 31)) : R;
      voffA = (unsigned)(R * K + C) * 2u; voffB = (unsigned)(Rb * K + C) * 2u; }
    const size_t rstep = (size_t)64 * K * 2;
    const size_t kstep = (size_t)(BK * 2);
    const size_t hstep = (size_t)HALF * K * 2;
    const size_t tstep = 2 * hstep;
    const unsigned ldsw = (unsigned)wid * 1024u;
    const int aoff = lds_byte(wr * 64 + fr, fq * 8), boff = lds_byte(wc * 32 + fr, fq * 8);
#define PG8_SA(b, h) (((b) * 2 + (h)) * HTB)
#define PG8_SB(b, h) ((4 + (b) * 2 + (h)) * HTB)
#define PG8_STAGE(bufoff, gbase, voff) do { _Pragma("unroll") for (int _i = 0; _i < 2; ++_i) \
        __builtin_amdgcn_global_load_lds((const unsigned*)((const char*)(gbase) + _i * rstep + (voff)), (LAS unsigned*)(lds + (bufoff) + ldsw + _i * 8192), 16, 0, 0); } while (0)
#define PG8_LDA(dst, b, h) do { _Pragma("unroll") for (int m = 0; m < 4; ++m) _Pragma("unroll") for (int k = 0; k < 2; ++k) dst[m][k] = *(const LAS bf16x8*)(lds + PG8_SA(b, h) + aoff + m * 2048 + k * 1024); } while (0)
#define PG8_LDB(dst, b, h) do { _Pragma("unroll") for (int n = 0; n < 2; ++n) _Pragma("unroll") for (int k = 0; k < 2; ++k) dst[n][k] = *(const LAS bf16x8*)(lds + PG8_SB(b, h) + boff + n * 2048 + k * 1024); } while (0)
#define PG8_MMA(ai, bj, At, Bt) do { __builtin_amdgcn_s_setprio(1); _Pragma("unroll") for (int m = 0; m < 4; ++m) _Pragma("unroll") for (int n = 0; n < 2; ++n) _Pragma("unroll") for (int k = 0; k < 2; ++k) \
        acc[ai][bj][m][n] = __builtin_amdgcn_mfma_f32_16x16x32_bf16(Bt[n][k], At[m][k], acc[ai][bj][m][n], 0, 0, 0); __builtin_amdgcn_s_setprio(0); } while (0)
#define PG8_WAIT_V(n) asm volatile("s_waitcnt vmcnt(%0)" :: "n"(n) : "memory")
#define PG8_WAIT_L(n) asm volatile("s_waitcnt lgkmcnt(" #n ")" ::: "memory")
#define PG8_BAR __builtin_amdgcn_s_barrier()
#define PG8_SCHED __builtin_amdgcn_sched_barrier(0)
    Unit cur, nxt; int ui = 0;
    if (!S.next(0, cur)) return;
    f32x4 acc[2][2][4][2];
#pragma unroll
    for (int a = 0; a < 2; ++a)
#pragma unroll
        for (int b = 0; b < 2; ++b)
#pragma unroll
            for (int m = 0; m < 4; ++m)
#pragma unroll
                for (int n = 0; n < 2; ++n) acc[a][b][m][n] = (f32x4){0.f, 0.f, 0.f, 0.f};
    bf16x8 At[4][2], B0[2][2], B1[2][2];
    const char* cA = (const char*)g.A + (size_t)cur.pm * tstep; const char* cB = (const char*)g.Bt + (size_t)cur.pn * tstep;
    S.a_ready(cur);
    typename Epi::Pre pre; E.prefetch(pre, cur, lds, ui, wid, fresh_lane());
    PG8_STAGE(PG8_SB(0, 0), cB, voffB); PG8_STAGE(PG8_SB(0, 1), cB + hstep, voffB); PG8_STAGE(PG8_SA(0, 0), cA, voffA); PG8_STAGE(PG8_SA(0, 1), cA + hstep, voffA);
    if (wr == 1) PG8_BAR;
    PG8_WAIT_V(2); PG8_BAR;
    PG8_STAGE(PG8_SB(1, 0), cB + kstep, voffB); PG8_STAGE(PG8_SA(1, 0), cA + kstep, voffA); PG8_STAGE(PG8_SB(1, 1), cB + hstep + kstep, voffB);
    PG8_WAIT_V(0); PG8_BAR;
    for (;;) {
        const bool has_next = S.next(ui + 1, nxt);
        const char* nA = has_next ? (const char*)g.A + (size_t)nxt.pm * tstep : cA; const char* nB = has_next ? (const char*)g.Bt + (size_t)nxt.pn * tstep : cB;
#define PG8_ITER(t, W12) do { \
            const bool last = ((t) == nt - 2); \
            const char* a1 = cA + (size_t)((t) + 1) * kstep; \
            const char* a2 = last ? nA : cA + (size_t)((t) + 2) * kstep; const char* b2 = last ? nB : cB + (size_t)((t) + 2) * kstep; \
            const char* a3 = a2 + kstep; const char* b3 = b2 + kstep; \
            if (last && has_next) S.a_ready(nxt); \
            PG8_LDB(B0, 0, 0); PG8_LDB(B1, 0, 1); PG8_SCHED; PG8_LDA(At, 0, 0); PG8_STAGE(PG8_SA(1, 1), a1 + hstep, voffA); \
            PG8_WAIT_V(W12); PG8_WAIT_L(0); PG8_BAR; PG8_MMA(0, 0, At, B0); PG8_MMA(0, 1, At, B1); PG8_BAR; PG8_SCHED; \
            PG8_LDA(At, 0, 1); PG8_STAGE(PG8_SB(0, 0), b2, voffB); PG8_STAGE(PG8_SB(0, 1), b2 + hstep, voffB); PG8_STAGE(PG8_SA(0, 0), a2, voffA); \
            PG8_WAIT_V(W12); PG8_WAIT_L(0); PG8_BAR; PG8_MMA(1, 0, At, B0); PG8_MMA(1, 1, At, B1); PG8_BAR; PG8_SCHED; \
            PG8_LDB(B0, 1, 0); PG8_LDB(B1, 1, 1); PG8_SCHED; PG8_LDA(At, 1, 0); PG8_STAGE(PG8_SA(0, 1), a2 + hstep, voffA); \
            PG8_WAIT_V(8); PG8_WAIT_L(0); PG8_BAR; PG8_MMA(0, 0, At, B0); PG8_MMA(0, 1, At, B1); PG8_BAR; PG8_SCHED; \
            PG8_LDA(At, 1, 1); PG8_STAGE(PG8_SB(1, 0), b3, voffB); PG8_STAGE(PG8_SB(1, 1), b3 + hstep, voffB); PG8_STAGE(PG8_SA(1, 0), a3, voffA); \
            PG8_WAIT_V(8); PG8_WAIT_L(0); PG8_BAR; PG8_MMA(1, 0, At, B0); PG8_MMA(1, 1, At, B1); PG8_BAR; PG8_SCHED; } while (0)
        if constexpr (Epi::PEEL && PEELX) { PG8_ITER(0, 8 + Epi::NST); for (int t = 2; t < nt; t += 2) PG8_ITER(t, 8); }
        else { for (int t = 0; t < nt; t += 2) PG8_ITER(t, 8); }
#undef PG8_ITER
        if constexpr (ALIGN_EPI) { if (wr == 0) PG8_BAR; }
        { const int le_ = fresh_lane(); E(acc, cur, wr, wc, le_ & 15, le_ >> 4, pre, lds); } S.done(cur);
        if (!has_next) break;
#pragma unroll
        for (int a = 0; a < 2; ++a)
#pragma unroll
            for (int b = 0; b < 2; ++b)
#pragma unroll
                for (int m = 0; m < 4; ++m)
#pragma unroll
                    for (int n = 0; n < 2; ++n) acc[a][b][m][n] = (f32x4){0.f, 0.f, 0.f, 0.f};
        cur = nxt; cA = nA; cB = nB; ++ui; E.prefetch(pre, cur, lds, ui, wid, fresh_lane());
        if constexpr (ALIGN_EPI) { if (wr == 1) PG8_BAR; }
    }
    PG8_WAIT_V(0);
    if constexpr (!ALIGN_EPI) { if (wr == 0) PG8_BAR; }
    PG8_BAR;
#undef PG8_SA
#undef PG8_SB
#undef PG8_STAGE
#undef PG8_LDA
#undef PG8_LDB
#undef PG8_MMA
#undef PG8_WAIT_V
#undef PG8_WAIT_L
#undef PG8_BAR
#undef PG8_SCHED
}
}

#define SBAR() __builtin_amdgcn_sched_barrier(0)
__device__ __forceinline__ int crow(int r, int hi) { return (r & 3) + 8 * (r >> 2) + 4 * hi; }
__device__ __forceinline__ int v_st(int k, int c) { const int kk = (k & ~0xC) | ((k & 4) << 1) | ((k & 8) >> 1); return ((kk >> 3) * 4 + (c >> 5)) * 512 + ((kk & 7) * 32 + (c & 31)) * 2; }
__device__ __forceinline__ int v_rd_base(int lane) { return ((lane & 3) << 3) | (((lane >> 2) & 3) << 6) | (((lane >> 4) & 1) << 5) | (((lane >> 5) & 1) << 8); }
constexpr int v_rd_off(int d0, int ks, int half) { return d0 * 512 + ks * 4096 + half * 2048; }
template <int OFF> __device__ __forceinline__ s16x4 tr_read(int vb) {
  s16x4 r; asm volatile("ds_read_b64_tr_b16 %0, %1 offset:%2" : "=&v"(r) : "v"(vb), "i"(OFF) : "memory"); return r;
}
template <int D0> __device__ __forceinline__ void pv_one(f32x16& od, int vb, bf16x8 pa0, bf16x8 pa1, bf16x8 pa2, bf16x8 pa3) {
  const s16x4 l0 = tr_read<v_rd_off(D0, 0, 0)>(vb), h0 = tr_read<v_rd_off(D0, 0, 1)>(vb), l1 = tr_read<v_rd_off(D0, 1, 0)>(vb), h1 = tr_read<v_rd_off(D0, 1, 1)>(vb);
  const s16x4 l2 = tr_read<v_rd_off(D0, 2, 0)>(vb), h2 = tr_read<v_rd_off(D0, 2, 1)>(vb), l3 = tr_read<v_rd_off(D0, 3, 0)>(vb), h3 = tr_read<v_rd_off(D0, 3, 1)>(vb);
  asm volatile("s_waitcnt lgkmcnt(0)" ::: "memory"); SBAR();
#define PK(L, H) (bf16x8){L[0], L[1], L[2], L[3], H[0], H[1], H[2], H[3]}
  od = __builtin_amdgcn_mfma_f32_32x32x16_bf16(pa0, PK(l0, h0), od, 0, 0, 0);
  od = __builtin_amdgcn_mfma_f32_32x32x16_bf16(pa1, PK(l1, h1), od, 0, 0, 0);
  od = __builtin_amdgcn_mfma_f32_32x32x16_bf16(pa2, PK(l2, h2), od, 0, 0, 0);
  od = __builtin_amdgcn_mfma_f32_32x32x16_bf16(pa3, PK(l3, h3), od, 0, 0, 0);
#undef PK
}
__device__ __forceinline__ void pv_d0(f32x16* o, int vb, bf16x8 pa0, bf16x8 pa1, bf16x8 pa2, bf16x8 pa3) {
  pv_one<0>(o[0], vb, pa0, pa1, pa2, pa3); pv_one<1>(o[1], vb, pa0, pa1, pa2, pa3); pv_one<2>(o[2], vb, pa0, pa1, pa2, pa3); pv_one<3>(o[3], vb, pa0, pa1, pa2, pa3);
}
#define PK4(P, BASE, OUT) do { unsigned a0 = cvt_pk_bf16(P[BASE + 0], P[BASE + 1]), a1 = cvt_pk_bf16(P[BASE + 2], P[BASE + 3]);   \
    unsigned b0 = cvt_pk_bf16(P[BASE + 4], P[BASE + 5]), b1 = cvt_pk_bf16(P[BASE + 6], P[BASE + 7]);                              \
    auto r0 = __builtin_amdgcn_permlane32_swap(a0, b0, false, false); auto r1 = __builtin_amdgcn_permlane32_swap(a1, b1, false, false); \
    u32x4 w = {r0[0], r1[0], r0[1], r1[1]}; OUT = *reinterpret_cast<bf16x8*>(&w); } while (0)
__device__ __forceinline__ float half_swap_max(float v) { auto rr = __builtin_amdgcn_permlane32_swap(__float_as_uint(v), __float_as_uint(v), false, false); return fmaxf(__uint_as_float(rr[0]), __uint_as_float(rr[1])); }
__device__ __forceinline__ float half_swap_add(float v) { auto rr = __builtin_amdgcn_permlane32_swap(__float_as_uint(v), __float_as_uint(v), false, false); return __uint_as_float(rr[0]) + __uint_as_float(rr[1]); }

template <int D0, int KS0> __device__ __forceinline__ void pv_half_one(f32x16& od, int vb, bf16x8 pa, bf16x8 pb) {
  const s16x4 l0 = tr_read<v_rd_off(D0, KS0, 0)>(vb), h0 = tr_read<v_rd_off(D0, KS0, 1)>(vb), l1 = tr_read<v_rd_off(D0, KS0 + 1, 0)>(vb), h1 = tr_read<v_rd_off(D0, KS0 + 1, 1)>(vb);
  asm volatile("s_waitcnt lgkmcnt(0)" ::: "memory"); SBAR();
#define PK(L, H) (bf16x8){L[0], L[1], L[2], L[3], H[0], H[1], H[2], H[3]}
  od = __builtin_amdgcn_mfma_f32_32x32x16_bf16(pa, PK(l0, h0), od, 0, 0, 0);
  od = __builtin_amdgcn_mfma_f32_32x32x16_bf16(pb, PK(l1, h1), od, 0, 0, 0);
#undef PK
}
template <int KS0> __device__ __forceinline__ void pv_half(f32x16* o, int vb, bf16x8 pa, bf16x8 pb) {
  pv_half_one<0, KS0>(o[0], vb, pa, pb); pv_half_one<1, KS0>(o[1], vb, pa, pb); pv_half_one<2, KS0>(o[2], vb, pa, pb); pv_half_one<3, KS0>(o[3], vb, pa, pb);
}

namespace dwa {
constexpr int SLOT = 32768;
constexpr int OFF_WS = 2 * SLOT, OFF_STG = OFF_WS + 8 * 256, LDS_BYTES = OFF_STG + 8 * 8192;
constexpr float C_QK = 0.08838834764831845f * LOG2E;
#define KSWZ128(row, colB) ((row) * 256 + ((colB) ^ (((row) & 15) << 4)))
__device__ __forceinline__ void dw_glds16(const void* gsrc, unsigned lds_dst) { unsigned keep;
  asm volatile("s_mov_b32 %0, m0\n\ts_mov_b32 m0, %2\n\ts_nop 0\n\tglobal_load_lds_dwordx4 %1, off\n\ts_mov_b32 m0, %0" : "=&s"(keep) : "v"(gsrc), "s"(lds_dst) : "memory"); }
constexpr float DW_THR = 8.f / C_QK;
template <int KT, bool U0, bool U1, bool FIRST>
__device__ __forceinline__ void tile(f32x16 (&o)[4], float& m_reg, float& l_reg, const bf16x8 (&qr)[8], const char* Kt, int vslot, float* al_l, int qh, float nsl, const f32x16& cb0, const f32x16& cb1) {
  const int ln_ = fresh_lane(), r32 = ln_ & 31, hi = ln_ >> 5, vbase = vslot + v_rd_base(ln_);
  const float base = (float)(32 * qh + r32 - 4 * hi);
  f32x16 p0 = {}, p1 = {};
  {
    const char* k0 = Kt + r32 * 256, * k1 = k0 + 32 * 256; const int sw = (r32 & 15) << 4, hb = hi * 16;
#define KRD(d0_, A_, B_) do { const int cb_ = ((d0_) * 32 + hb) ^ sw; if (U0) A_ = *reinterpret_cast<const bf16x8*>(k0 + cb_); if (U1) B_ = *reinterpret_cast<const bf16x8*>(k1 + cb_); } while (0)
#define KMM(d0_, A_, B_) do { if (U0) p0 = __builtin_amdgcn_mfma_f32_32x32x16_bf16(A_, qr[d0_], p0, 0, 0, 0); if (U1) p1 = __builtin_amdgcn_mfma_f32_32x32x16_bf16(B_, qr[d0_], p1, 0, 0, 0); } while (0)
    bf16x8 a0 = {}, b0 = {}, a1 = {}, b1 = {}, a2 = {}, b2 = {};
    KRD(0, a0, b0); KRD(1, a1, b1);
    KRD(2, a2, b2); SBAR(); if (KT == 0) { p0 = __builtin_amdgcn_mfma_f32_32x32x16_bf16(a0, qr[0], cb0, 0, 0, 0); p1 = __builtin_amdgcn_mfma_f32_32x32x16_bf16(b0, qr[0], cb1, 0, 0, 0); } else KMM(0, a0, b0);
    KRD(3, a0, b0); SBAR(); KMM(1, a1, b1); KRD(4, a1, b1); SBAR(); KMM(2, a2, b2);
    KRD(5, a2, b2); SBAR(); KMM(3, a0, b0); KRD(6, a0, b0); SBAR(); KMM(4, a1, b1); KRD(7, a1, b1); SBAR(); KMM(5, a2, b2);
    SBAR(); KMM(6, a0, b0); SBAR(); KMM(7, a1, b1);
#undef KRD
#undef KMM
  }
  float pmax = -1e30f;
#define DW_SCORE(P, HALF) do { _Pragma("unroll") for (int rr = 0; rr < 16; ++rr) { const float d = base - (float)((rr & 3) + 8 * (rr >> 2) + 32 * (HALF));     \
      if (KT == 0) { }                                                                              \
      else if (KT < 0) P[rr] = d <= 0.f ? fmaf(d + 64.f, nsl, P[rr]) : -1e30f;                      \
      else P[rr] = d >= 0.f ? fmaf(64.f - d, nsl, P[rr]) : -1e30f;                                  \
      pmax = fmaxf(pmax, P[rr]); } } while (0)
  if (U0) DW_SCORE(p0, 0);
  if (U1) DW_SCORE(p1, 1);
#undef DW_SCORE
  pmax = half_swap_max(pmax);
  float alpha = 1.f;
  const bool keep = !FIRST && __all(pmax - m_reg <= DW_THR);
  if (!keep) { const float mn = fmaxf(m_reg, pmax); alpha = __builtin_amdgcn_exp2f((m_reg - mn) * C_QK); m_reg = mn; }
  const float mC = -m_reg * C_QK;
  float ps = 0.f;
#pragma unroll
  for (int rr = 0; rr < 16; ++rr) { if (U0) { p0[rr] = __builtin_amdgcn_exp2f(fmaf(p0[rr], C_QK, mC)); ps += p0[rr]; } if (U1) { p1[rr] = __builtin_amdgcn_exp2f(fmaf(p1[rr], C_QK, mC)); ps += p1[rr]; } }
  ps = half_swap_add(ps); l_reg = l_reg * alpha + ps;
  bf16x8 pa0 = {}, pa1 = {}, pa2 = {}, pa3 = {};
  if (U0) { PK4(p0, 0, pa0); PK4(p0, 8, pa1); }
  if (U1) { PK4(p1, 0, pa2); PK4(p1, 8, pa3); }
  if (!FIRST && !keep) {
    if (hi == 0) al_l[r32] = alpha; asm volatile("s_waitcnt lgkmcnt(0)" ::: "memory");
#pragma unroll
    for (int rr = 0; rr < 16; ++rr) { const float al = al_l[crow(rr, hi)];
#pragma unroll
      for (int d = 0; d < 4; ++d) o[d][rr] *= al; }
    asm volatile("s_waitcnt lgkmcnt(0)" ::: "memory"); }
  SBAR();
  if (U0 && U1) pv_d0(o, vbase, pa0, pa1, pa2, pa3);
  else if (U0) pv_half<0>(o, vbase, pa0, pa1);
  else pv_half<2>(o, vbase, pa2, pa3);
}
__device__ __forceinline__ void item(const bf16_t* __restrict__ qkvs, bf16_t* __restrict__ og, float* __restrict__ lse, int seqbase, int S, int g, int dil, int res, int n0, int L, int h, char* lds, int wave0) {
  const int lane = fresh_lane(), wid = wave0, tid = wid * 64 + lane, r32 = lane & 31, hi = lane >> 5;
  const int qh = wid & 1;
  const int nblk = (S / dil) >> 6, nend = n0 + L;
  const bf16_t* Qs = qkvs + ((size_t)((g * 3 + 0) * NH + h) * CHUNK + seqbase) * 128;
  const bf16_t* Ks = qkvs + ((size_t)((g * 3 + 1) * NH + h) * CHUNK + seqbase) * 128;
  const bf16_t* Vs = qkvs + ((size_t)((g * 3 + 2) * NH + h) * CHUNK + seqbase) * 128;
  const int a = 32 * qh + r32;
  int nb = n0 + (wid >> 1);
  bf16x8 qr[8];
#define DW_QLOAD() do { const int lq_ = fresh_lane(); const long qt_ = (long)(64 * nb + 32 * qh + (lq_ & 31)) * dil + res; const int hq_ = lq_ >> 5; _Pragma("unroll") for (int d0 = 0; d0 < 8; ++d0) qr[d0] = *(const bf16x8*)(Qs + qt_ * 128 + d0 * 16 + hq_ * 8); } while (0)
  DW_QLOAD();
  float* al_l = (float*)(lds + OFF_WS + wid * 256);
  float m_reg = -1e30f, l_reg = 0.f; f32x16 o[4] = {};
  const float nsl = -__builtin_amdgcn_exp2f(-0.5f * (float)(h + 1)) * (float)dil * (LOG2E / C_QK);
  f32x16 cb0, cb1;
#pragma unroll
  for (int rr = 0; rr < 16; ++rr) { const float d = (float)(a - 4 * hi - ((rr & 3) + 8 * (rr >> 2))); cb0[rr] = __builtin_fabsf(d) * nsl; cb1[rr] = __builtin_fabsf(d - 32.f) * nsl; }
  const int kmin = n0 == 0 ? 0 : n0 - 1, kmax = nend < nblk ? nend : nblk - 1;
  int doff[4];
#pragma unroll
  for (int i = 0; i < 4; ++i) { const int ob = 1024 * ((4 * wid + i) & 15) + 16 * lane;
    if (wid < 4) { const int row = ob >> 8, cs = (ob & 255) >> 4, ch = cs ^ (row & 15); doff[i] = row * dil * 128 + ch * 8; }
    else { const int sub = ob >> 9, within = ob & 511, kk = (sub >> 2) * 8 + (within >> 6), kq = (kk & ~0xC) | ((kk & 4) << 1) | ((kk & 8) >> 1), c = (sub & 3) * 32 + ((within & 63) >> 1); doff[i] = kq * dil * 128 + c; } }
  const bf16_t* const dbase = (wid < 4 ? Ks : Vs) + (long)res * 128;
#define DW_DMA(k, slot) do { const bf16_t* tb_ = dbase + (long)(64 * (k)) * dil * 128; const unsigned d_ = (unsigned)__builtin_amdgcn_readfirstlane((unsigned)(uintptr_t)(lds + (slot) * SLOT + 4096 * wid)); \
    dw_glds16(tb_ + doff[0], d_); dw_glds16(tb_ + doff[1], d_ + 1024u); dw_glds16(tb_ + doff[2], d_ + 2048u); dw_glds16(tb_ + doff[3], d_ + 3072u); } while (0)
#define DW_WAIT_BAR() asm volatile("s_waitcnt vmcnt(0) lgkmcnt(0)\n\ts_barrier" ::: "memory")
#define DW_EPI() do { const int ln_ = fresh_lane(), r32e = ln_ & 31, hie = ln_ >> 5;     \
    if (hie == 0) al_l[r32e] = __builtin_amdgcn_rcpf(l_reg); asm volatile("s_waitcnt lgkmcnt(0)" ::: "memory"); \
    bf16_t* stg = (bf16_t*)(lds + OFF_STG + wid * 8192); \
    _Pragma("unroll") for (int rr = 0; rr < 16; ++rr) { const int row = crow(rr, hie); const float li = al_l[row]; \
      _Pragma("unroll") for (int d = 0; d < 4; ++d) { const unsigned w = cvt_pk_bf16(o[d][rr] * li, 0.f); stg[row * 128 + d * 32 + r32e] = (bf16_t)(w & 0xffffu); } } \
    asm volatile("s_waitcnt lgkmcnt(0)" ::: "memory"); \
    const int er = ln_ >> 4, ec = (ln_ & 15) * 8; \
    _Pragma("unroll") for (int i = 0; i < 8; ++i) { const int row = er + 4 * i; const long tok = seqbase + (long)(64 * nb + 32 * qh + row) * dil + res; \
      *(u32x4*)(og + (tok * 3 + g) * DM + h * 128 + ec) = *(const u32x4*)(stg + row * 128 + ec); } \
    if (hie == 0) lse[((seqbase + (long)(64 * nb + 32 * qh + r32e) * dil + res) * 3 + g) * NH + h] = m_reg * C_QK + __builtin_amdgcn_logf(l_reg);     \
    asm volatile("s_waitcnt lgkmcnt(0)" ::: "memory"); } while (0)
  DW_DMA(kmin, kmin & 1); DW_WAIT_BAR();
  for (int k = kmin; k <= kmax; ++k) {
    if (k < kmax) DW_DMA(k + 1, (k + 1) & 1);
    bool between = false;
    const int kt = k - nb;
    if (nb < nend && kt >= -1 && kt <= 1) {
      const char* Kt = lds + (k & 1) * SLOT; const int vb_ = (int)(uintptr_t)(lds + (k & 1) * SLOT + 16384);
      if (kt == 0) { if (nb == 0) tile<0, true, true, true>(o, m_reg, l_reg, qr, Kt, vb_, al_l, qh, nsl, cb0, cb1); else tile<0, true, true, false>(o, m_reg, l_reg, qr, Kt, vb_, al_l, qh, nsl, cb0, cb1); }
      else if (kt < 0) { if (qh) tile<-1, false, true, true>(o, m_reg, l_reg, qr, Kt, vb_, al_l, qh, nsl, cb0, cb1); else tile<-1, true, true, true>(o, m_reg, l_reg, qr, Kt, vb_, al_l, qh, nsl, cb0, cb1); }
      else { if (qh) tile<1, true, true, false>(o, m_reg, l_reg, qr, Kt, vb_, al_l, qh, nsl, cb0, cb1); else tile<1, true, false, false>(o, m_reg, l_reg, qr, Kt, vb_, al_l, qh, nsl, cb0, cb1); }
    } else if (nb < nend && kt == 2) {
      between = true;
      const int nbo = nb; nb += 4;
      if (nb < nend) DW_QLOAD();
      { const int nbn = nb; nb = nbo; DW_EPI(); nb = nbn; }
      if (nb < nend) { m_reg = -1e30f; l_reg = 0.f;
#pragma unroll
        for (int d = 0; d < 4; ++d) o[d] = f32x16{}; }
    }
    if (between) asm volatile("s_waitcnt vmcnt(8) lgkmcnt(0)\n\ts_barrier" ::: "memory"); else DW_WAIT_BAR();
  }
  if (nb < nend) DW_EPI();
#undef DW_DMA
#undef DW_WAIT_BAR
#undef DW_QLOAD
#undef DW_EPI
}
}

namespace mla {
constexpr int NW = 8, QBLK = 32, KVBLK = 64;
constexpr float SCALE = 0.07216878364870322f;
constexpr float THR = 8.f;
constexpr int LDQ = NQ, LDKV = NKV, LDKR = 64, LDO = DM;
constexpr int SHM_V = KVBLK * 128 * 2, SHM_K = KVBLK * 192 * 2;
constexpr int OFF_V = 0, OFF_K = 2 * SHM_V, OFF_WS = 2 * SHM_V + 2 * SHM_K, OFF_QR = OFF_WS + NW * 64 * 4, LDS_BYTES = OFF_QR + NW * 4096;
#define KSWZ192(row, colB) ((row) * 384 + ((colB) ^ ((((row) >> 1) & 7) << 4)))

__device__ __forceinline__ void partialSM(f32x16& p0, f32x16& p1, float& m_reg, float& mn, float& alpha) {
  constexpr float C = SCALE * LOG2E;
  float pmax = p0[0];
#pragma unroll
  for (int r = 1; r < 16; ++r) pmax = fmaxf(pmax, p0[r]);
#pragma unroll
  for (int r = 0; r < 16; ++r) pmax = fmaxf(pmax, p1[r]);
  pmax = half_swap_max(pmax);
  if (__builtin_expect(__all(pmax - m_reg <= THR / SCALE), 1)) { mn = m_reg; alpha = 1.f; }
  else { mn = fmaxf(m_reg, pmax); alpha = __builtin_amdgcn_exp2f((m_reg - mn) * C); m_reg = mn; }
  const float mnC = -mn * C;
#pragma unroll
  for (int r = 0; r < 16; ++r) p0[r] = fmaf(p0[r], C, mnC);
#pragma unroll
  for (int r = 0; r < 16; ++r) p1[r] = fmaf(p1[r], C, mnC);
}
__device__ __forceinline__ void finishSM(f32x16& p0, f32x16& p1, float alpha, float& l_reg, bf16x8& pa0, bf16x8& pa1, bf16x8& pa2, bf16x8& pa3) {
#pragma unroll
  for (int r = 0; r < 16; ++r) p0[r] = __builtin_amdgcn_exp2f(p0[r]);
#pragma unroll
  for (int r = 0; r < 16; ++r) p1[r] = __builtin_amdgcn_exp2f(p1[r]);
  float ps = 0;
#pragma unroll
  for (int r = 0; r < 16; ++r) ps += p0[r];
#pragma unroll
  for (int r = 0; r < 16; ++r) ps += p1[r];
  ps = half_swap_add(ps);
  l_reg = l_reg * alpha + ps;
  PK4(p0, 0, pa0); PK4(p0, 8, pa1); PK4(p1, 0, pa2); PK4(p1, 8, pa3);
}
__device__ __forceinline__ void qkt(f32x16& p0, f32x16& p1, const char* Ks, const bf16x8* qr, const char* qrl, int r32, int hi) {
  p0 = f32x16{}; p1 = f32x16{};
#pragma unroll
  for (int d0 = 0; d0 < 12; ++d0) { const int cb = (d0 * 16 + hi * 8) * 2;
    const bf16x8 b0 = *reinterpret_cast<const bf16x8*>(Ks + KSWZ192(r32, cb));
    const bf16x8 b1 = *reinterpret_cast<const bf16x8*>(Ks + KSWZ192(32 + r32, cb));
    const bf16x8 qf = d0 < 8 ? qr[d0 < 8 ? d0 : 0] : *reinterpret_cast<const bf16x8*>(qrl + (d0 - 8) * 1024);
    p0 = __builtin_amdgcn_mfma_f32_32x32x16_bf16(b0, qf, p0, 0, 0, 0);
    p1 = __builtin_amdgcn_mfma_f32_32x32x16_bf16(b1, qf, p1, 0, 0, 0); }
}
__device__ __forceinline__ void qkt_fsm(f32x16& q0, f32x16& q1, const char* Ks, const bf16x8* qr, const char* qrl, int r32, int hi,
                                        f32x16& s0, f32x16& s1, float alpha, float& l_reg, bf16x8& pa0, bf16x8& pa1, bf16x8& pa2, bf16x8& pa3) {
  q0 = f32x16{}; q1 = f32x16{};
  const char* ka = Ks + r32 * 384, * kb = ka + 32 * 384; const int sw = ((r32 >> 1) & 7) << 4;
#define KF(d0_, A_, B_, Q_) do { const int cb_ = (((d0_) * 16 + hi * 8) * 2); const int o_ = (cb_ & ~127) | ((cb_ & 127) ^ sw); A_ = *reinterpret_cast<const bf16x8*>(ka + o_); B_ = *reinterpret_cast<const bf16x8*>(kb + o_); \
    if ((d0_) >= 8) Q_ = *reinterpret_cast<const bf16x8*>(qrl + ((d0_) - 8) * 1024); } while (0)
  bf16x8 a0, b0, qf0 = {};
  float ps = 0.f;
  KF(0, a0, b0, qf0);
#define STEP(d0_, SLICE) do { \
    q0 = __builtin_amdgcn_mfma_f32_32x32x16_bf16(a0, (d0_) < 8 ? qr[(d0_) < 8 ? (d0_) : 0] : qf0, q0, 0, 0, 0); q1 = __builtin_amdgcn_mfma_f32_32x32x16_bf16(b0, (d0_) < 8 ? qr[(d0_) < 8 ? (d0_) : 0] : qf0, q1, 0, 0, 0); \
    if ((d0_) < 11) KF((d0_) + 1, a0, b0, qf0); \
    SLICE; SBAR(); } while (0)
#define EX4(S_, i_) do { S_[i_] = __builtin_amdgcn_exp2f(S_[i_]); S_[(i_) + 1] = __builtin_amdgcn_exp2f(S_[(i_) + 1]); S_[(i_) + 2] = __builtin_amdgcn_exp2f(S_[(i_) + 2]); S_[(i_) + 3] = __builtin_amdgcn_exp2f(S_[(i_) + 3]); } while (0)
#define AD4(S_, i_) do { ps += S_[i_]; ps += S_[(i_) + 1]; ps += S_[(i_) + 2]; ps += S_[(i_) + 3]; } while (0)
  STEP(0, { EX4(s0, 0); });
  STEP(1, { EX4(s0, 4); AD4(s0, 0); });
  STEP(2, { EX4(s0, 8); AD4(s0, 4); });
  STEP(3, { EX4(s0, 12); AD4(s0, 8); });
  STEP(4, { AD4(s0, 12); PK4(s0, 0, pa0); });
  STEP(5, { PK4(s0, 8, pa1); EX4(s1, 0); });
  STEP(6, { EX4(s1, 4); AD4(s1, 0); });
  STEP(7, { EX4(s1, 8); AD4(s1, 4); });
  STEP(8, { EX4(s1, 12); AD4(s1, 8); });
  STEP(9, { AD4(s1, 12); PK4(s1, 0, pa2); });
  STEP(10, { PK4(s1, 8, pa3); });
  STEP(11, { ps = half_swap_add(ps); l_reg = l_reg * alpha + ps; });
#undef EX4
#undef AD4
#undef STEP
#undef KF
}
__device__ __forceinline__ void glds16(const void* gsrc, unsigned lds_dst) { unsigned keep;
  asm volatile("s_mov_b32 %0, m0\n\ts_mov_b32 m0, %2\n\ts_nop 0\n\tglobal_load_lds_dwordx4 %1, off\n\ts_mov_b32 m0, %0" : "=&s"(keep) : "v"(gsrc), "s"(lds_dst) : "memory"); }
#define MLA_WAIT_BAR() asm volatile("s_waitcnt vmcnt(0) lgkmcnt(0)\n\ts_barrier" ::: "memory")
__device__ __forceinline__ void attn_unit(const bf16_t* __restrict__ Qb, const bf16_t* __restrict__ Kn, const bf16_t* __restrict__ Kr, const bf16_t* __restrict__ Vh, bf16_t* __restrict__ Ob, int seq, char* lds, int wave0) {
  const int lane = fresh_lane(), wid = wave0, r32 = lane & 31, hi = lane >> 5;
  char* V_lds = lds + OFF_V; char* K_lds = lds + OFF_K;
  float* ws = (float*)(lds + OFF_WS) + wid * 64; float* li_l = ws; float* al_l = ws + 32;
  float m_reg = -1e30f, l_reg = 0; f32x16 o[4] = {}; bf16x8 qr[8];
  const bf16_t* Qw = Qb + (long)(wid * QBLK + r32) * LDQ + hi * 8;
#pragma unroll
  for (int d0 = 0; d0 < 8; ++d0) qr[d0] = *reinterpret_cast<const bf16x8*>(Qw + d0 * 16);
  char* const qrl = lds + OFF_QR + wid * 4096 + lane * 16;
  { const unsigned qd_ = (unsigned)__builtin_amdgcn_readfirstlane((unsigned)(uintptr_t)(lds + OFF_QR + wid * 4096));
#pragma unroll
    for (int d0 = 0; d0 < 4; ++d0) glds16(Qw + (8 + d0) * 16, qd_ + 1024u * d0); }
  const bf16_t* ksrc[3]; long kstep[3]; const bf16_t* vsrc[2];
#pragma unroll
  for (int i = 0; i < 3; ++i) { const int ob = 1024 * (3 * wid + i) + 16 * lane, row = ob / 384, cs = (ob % 384) >> 4, ch = (cs & ~7) | ((cs & 7) ^ ((row >> 1) & 7));
    const bool nope = ch < 16; ksrc[i] = nope ? Kn + (long)row * LDKV + ch * 8 : Kr + (long)row * LDKR + (ch - 16) * 8; kstep[i] = nope ? (long)KVBLK * LDKV : (long)KVBLK * LDKR; }
#pragma unroll
  for (int i = 0; i < 2; ++i) { const int ob = 1024 * (2 * wid + i) + 16 * lane, sub = ob >> 9, within = ob & 511, kk = (sub >> 2) * 8 + (within >> 6), k = (kk & ~0xC) | ((kk & 4) << 1) | ((kk & 8) >> 1), c = (sub & 3) * 32 + ((within & 63) >> 1);
    vsrc[i] = Vh + (long)k * LDKV + c; }
  const unsigned kdst = (unsigned)(uintptr_t)K_lds + 3072u * (unsigned)wid, vdst = (unsigned)(uintptr_t)V_lds + 2048u * (unsigned)wid;
#define DMA_K(t) do { const unsigned d_ = (unsigned)__builtin_amdgcn_readfirstlane(kdst + ((t) & 1) * SHM_K); \
    glds16(ksrc[0] + (long)(t) * kstep[0], d_); glds16(ksrc[1] + (long)(t) * kstep[1], d_ + 1024u); glds16(ksrc[2] + (long)(t) * kstep[2], d_ + 2048u); } while (0)
#define DMA_V(t) do { const unsigned d_ = (unsigned)__builtin_amdgcn_readfirstlane(vdst + ((t) & 1) * SHM_V); \
    glds16(vsrc[0] + (long)(t) * KVBLK * LDKV, d_); glds16(vsrc[1] + (long)(t) * KVBLK * LDKV, d_ + 1024u); } while (0)
  const int vb0 = (int)(uintptr_t)V_lds + v_rd_base(lane);
#define RESC(a) do { if (__any((a) < 1.f)) { if (hi == 0) al_l[r32] = (a); asm volatile("s_waitcnt lgkmcnt(0)" ::: "memory"); \
    _Pragma("unroll") for (int d = 0; d < 4; ++d) _Pragma("unroll") for (int r = 0; r < 16; ++r) o[d][r] *= al_l[crow(r, hi)]; } } while (0)
  f32x16 pA0, pA1, pB0, pB1; float mnA, mnB, alA, alB; bf16x8 pa0, pa1, pa2, pa3; const int NT = seq / KVBLK;
  DMA_K(0); MLA_WAIT_BAR();
  DMA_K(1); DMA_V(0);
  qkt(pA0, pA1, K_lds, qr, qrl, r32, hi); partialSM(pA0, pA1, m_reg, mnA, alA);
  for (int j = 1; j + 1 < NT; j += 2) {
    MLA_WAIT_BAR(); DMA_K(j + 1); DMA_V(j);
    SBAR(); __builtin_amdgcn_s_setprio(1); qkt_fsm(pB0, pB1, K_lds + SHM_K, qr, qrl, r32, hi, pA0, pA1, alA, l_reg, pa0, pa1, pa2, pa3); __builtin_amdgcn_s_setprio(0); SBAR();
    pv_d0(o, vb0, pa0, pa1, pa2, pa3); partialSM(pB0, pB1, m_reg, mnB, alB);
    RESC(alB);
    MLA_WAIT_BAR(); DMA_K(j + 2); DMA_V(j + 1);
    SBAR(); __builtin_amdgcn_s_setprio(1); qkt_fsm(pA0, pA1, K_lds, qr, qrl, r32, hi, pB0, pB1, alB, l_reg, pa0, pa1, pa2, pa3); __builtin_amdgcn_s_setprio(0); SBAR();
    pv_d0(o, vb0 + SHM_V, pa0, pa1, pa2, pa3); partialSM(pA0, pA1, m_reg, mnA, alA);
    RESC(alA);
  }
  MLA_WAIT_BAR(); DMA_V(NT - 1);
  SBAR(); __builtin_amdgcn_s_setprio(1); qkt_fsm(pB0, pB1, K_lds + SHM_K, qr, qrl, r32, hi, pA0, pA1, alA, l_reg, pa0, pa1, pa2, pa3); __builtin_amdgcn_s_setprio(0); SBAR();
  pv_d0(o, vb0, pa0, pa1, pa2, pa3); partialSM(pB0, pB1, m_reg, mnB, alB);
  RESC(alB);
  finishSM(pB0, pB1, alB, l_reg, pa0, pa1, pa2, pa3); SBAR();
  MLA_WAIT_BAR();
  pv_d0(o, vb0 + SHM_V, pa0, pa1, pa2, pa3);
  if (hi == 0) li_l[r32] = l_reg; asm volatile("s_waitcnt lgkmcnt(0)" ::: "memory");
  asm volatile("s_waitcnt lgkmcnt(0)\n\ts_barrier" ::: "memory");
  bf16_t* stg = (bf16_t*)(lds + OFF_V + wid * 8192);
#pragma unroll
  for (int r = 0; r < 16; ++r) { const int row = crow(r, hi); const float li = __builtin_amdgcn_rcpf(li_l[row]);
#pragma unroll
    for (int d = 0; d < 4; ++d) { const unsigned w = cvt_pk_bf16(o[d][r] * li, 0.f); stg[row * 128 + d * 32 + r32] = (bf16_t)(w & 0xffffu); } }
  asm volatile("s_waitcnt lgkmcnt(0)" ::: "memory");
  const int er = lane >> 4, ec = (lane & 15) * 8;
#pragma unroll
  for (int i = 0; i < 8; ++i) { const int row = er + 4 * i;
    *(u32x4*)(Ob + (long)(wid * QBLK + row) * LDO + ec) = *(const u32x4*)(stg + row * 128 + ec); }
  asm volatile("s_waitcnt lgkmcnt(0)" ::: "memory");
  asm volatile("s_waitcnt lgkmcnt(0)\n\ts_barrier" ::: "memory");
#undef DMA_K
#undef DMA_V
#undef RESC
}
}

constexpr int NWAVES = 8;
constexpr int NBLK = 256;
constexpr size_t MiB = 1u << 20;
constexpr size_t WS_CTL = 0, WS_SS = 1 * MiB, CTL_ZERO_BYTES = 4 * MiB;
constexpr size_t WS_ROPE_C = 150 * MiB, WS_ROPE_S = 151 * MiB;
constexpr size_t WS_W = 4 * MiB;
constexpr size_t W_QKV = WS_W, W_WA = WS_W, W_UQ = WS_W + 4 * MiB, W_UKV = WS_W + 8 * MiB;
constexpr size_t W_O = WS_W + 72 * MiB, W_GU = WS_W + 80 * MiB, W_DN = WS_W + 124 * MiB;
constexpr size_t WS_H = 152 * MiB;
constexpr size_t WS_S = 312 * MiB;
constexpr size_t S_QKV = WS_S, S_OG = WS_S + 288 * MiB, S_LSE = WS_S + 384 * MiB, S_OA = WS_S + 386 * MiB;
constexpr size_t S_ACT = WS_S;
constexpr size_t S_KV = WS_S, S_A = WS_S, S_CQ = WS_S + 320 * MiB, S_CKV = WS_S + 360 * MiB, S_KR = WS_S + 400 * MiB, S_Q = WS_S + 405 * MiB, S_OB = WS_S + 645 * MiB;
constexpr size_t WS_END = WS_S + 805 * MiB;
static_assert(S_OA + (size_t)T_ALL * DM * 2 <= WS_END && S_Q + (size_t)T_ALL * NQ * 2 <= S_OB && S_OB + (size_t)T_ALL * DM * 2 <= WS_END && S_ACT + (size_t)T_ALL * DFF * 2 <= WS_END, "d_ws map");
static_assert(W_DN + (size_t)DM * DFF * 2 <= WS_H && W_QKV + (size_t)NQKV * DM * 2 <= W_O && WS_H + (size_t)T_ALL * DM * 2 <= WS_S && WS_SS + (size_t)9 * T_ALL * 8 <= CTL_ZERO_BYTES && W_DN + (size_t)DM * DFF * 2 <= WS_ROPE_C, "d_ws map");
constexpr int CW_TMO = 0, CW_CODE = 1, CW_BAR = 4096;

constexpr int RING_OFF = 0, RING_BYTES = 146432;
constexpr int LDSCTL_OFF = RING_BYTES, MISC_OFF = LDSCTL_OFF + 320;
constexpr int LDS_BYTES = 147456;
static_assert(MISC_OFF + 128 <= LDS_BYTES && dwa::LDS_BYTES <= RING_BYTES && mla::LDS_BYTES <= RING_BYTES && pg8::STAGE_BYTES + 4096 <= RING_BYTES, "LDS map");

#define RLX_AGENT __ATOMIC_RELAXED, __HIP_MEMORY_SCOPE_AGENT
#define LDS_WAIT() asm volatile("s_waitcnt lgkmcnt(0)" ::: "memory")
#define VM_WAIT() asm volatile("s_waitcnt vmcnt(0)" ::: "memory")
__device__ __forceinline__ unsigned f2bf(float f) { unsigned u = __builtin_bit_cast(unsigned, f); return (u + 0x7fffu + ((u >> 16) & 1u)) >> 16; }
__device__ __forceinline__ unsigned pk2(float lo, float hi) { return f2bf(lo) | (f2bf(hi) << 16); }

#define XB_TMO      128
#define XB_XCNT(j)  (256  + 64 * (j))
#define XB_XSUB(j)  (1280 + 64 * (j))
#define XB_XGEN(j)  (2304 + 64 * (j))
#define XB_TOP      3328
#define XB_TOPGEN   3392
#define XCD_BAR_WORDS 3456
#define XB_SPIN_CAP (1u << 18)
__device__ __forceinline__ unsigned xb_ld(unsigned* p)              { return __hip_atomic_load(p, __ATOMIC_RELAXED, __HIP_MEMORY_SCOPE_AGENT); }
__device__ __forceinline__ unsigned xb_add(unsigned* p, unsigned v) { return __hip_atomic_fetch_add(p, v, __ATOMIC_RELAXED, __HIP_MEMORY_SCOPE_AGENT); }
__device__ __forceinline__ unsigned xb_xcc_id() { return (unsigned)__builtin_amdgcn_s_getreg((3 << 11) | 20) & 0xFu; }
#define XB_SPIN(cond, bar) do { unsigned _sp = 0; while (cond) { __builtin_amdgcn_s_sleep(1); \
    if ((++_sp & 255u) == 0u) { if (xb_ld(&(bar)[XB_TMO])) break; if (_sp > XB_SPIN_CAP) { atomicAdd(&(bar)[XB_TMO], 1u); break; } } } } while (0)
struct XcdBarrier { unsigned* bar; unsigned x; volatile LAS unsigned* st; bool leader; };
__device__ __forceinline__ XcdBarrier xcd_barrier_post(unsigned* bar, volatile LAS unsigned* st) {
    XcdBarrier b; b.bar = bar; b.x = xb_xcc_id(); b.st = st; b.leader = threadIdx.x == 0;
    if (b.leader) (void)xb_add(&bar[XB_XCNT(b.x)], 1u);
    return b;
}
__device__ __forceinline__ void xcd_barrier_complete(unsigned* bar, unsigned x, unsigned& nloc, unsigned& nx) {
    const unsigned G = gridDim.x * gridDim.y * gridDim.z;
    unsigned sum, cnt, mine, sp = 0u;
    for (;;) {
        sum = 0u; cnt = 0u; mine = 0u;
#pragma unroll
        for (unsigned j = 0; j < 16; ++j) { const unsigned c = xb_ld(&bar[XB_XCNT(j)]); sum += c; cnt += (c > 0u) ? 1u : 0u; mine = (j == x) ? c : mine; }
        if (sum == G) break;
        __builtin_amdgcn_s_sleep(1);
        if ((++sp & 255u) == 0u) { if (xb_ld(&bar[XB_TMO])) break; if (sp > XB_SPIN_CAP) { atomicAdd(&bar[XB_TMO], 1u); break; } }
    }
    nloc = mine > 0u ? mine : 1u; nx = cnt > 0u ? cnt : 1u;
}
__device__ __forceinline__ void xcd_barrier(const XcdBarrier& b) {
    asm volatile("s_waitcnt vmcnt(0)" ::: "memory");
    __syncthreads();
    if (b.leader) {
        unsigned* bar = b.bar;
        __builtin_amdgcn_s_waitcnt(0);
        unsigned nloc = b.st[0], nx = b.st[1];
        if (nloc == 0u) { xcd_barrier_complete(bar, b.x, nloc, nx); b.st[0] = nloc; b.st[1] = nx; }
        const unsigned old = xb_add(&bar[XB_XSUB(b.x)], 1u);
        const unsigned gen = old / nloc;
        if (old + 1u == (gen + 1u) * nloc) {
            __builtin_amdgcn_fence(__ATOMIC_RELEASE, "agent");
            asm volatile("s_waitcnt vmcnt(0)" ::: "memory");
            const unsigned og = xb_add(&bar[XB_TOP], 1u);
            const unsigned tg = og / nx;
            if (og + 1u == (tg + 1u) * nx) xb_add(&bar[XB_TOPGEN], 1u);
            else XB_SPIN(xb_ld(&bar[XB_TOPGEN]) == tg, bar);
            __builtin_amdgcn_fence(__ATOMIC_ACQUIRE, "agent");
            xb_add(&bar[XB_XGEN(b.x)], 1u);
            asm volatile("s_waitcnt vmcnt(0)" ::: "memory");
        } else {
            XB_SPIN(xb_ld(&bar[XB_XGEN(b.x)]) == gen, bar);
            __builtin_amdgcn_fence(__ATOMIC_ACQUIRE, "agent");
            asm volatile("s_waitcnt vmcnt(0)" ::: "memory");
        }
    }
    __syncthreads();
}

__device__ __forceinline__ float shfl_xor_f(float v, int o, int lane) { return __int_as_float(__builtin_amdgcn_ds_bpermute((lane ^ o) << 2, __float_as_int(v))); }
__device__ __forceinline__ float wave_sum(float v, int lane) {
#pragma unroll
    for (int o = 1; o < 64; o <<= 1) v += shfl_xor_f(v, o, lane);
    return v;
}
template <int MODE> __device__ __forceinline__ int wmap(int c) {
    if (MODE == 1) return 256 * (c >> 7) + (c & 127);
    if (MODE == 2) return 256 * (c >> 7) + 128 + (c & 127);
    if (MODE == 3) { const int h = c / 192, w = c % 192; if (w < 128) return c; int j = w - 128;
        if (j < 32) return h * 192 + 128 + 8 * (j >> 2) + (j & 3); j -= 32; return h * 192 + 128 + 8 * (j >> 2) + 4 + (j & 3); }
    if (MODE == 4) { if (c < QLR + KVL) return c; int j = c - (QLR + KVL);
        if (j < 32) return QLR + KVL + 8 * (j >> 2) + (j & 3); j -= 32; return QLR + KVL + 8 * (j >> 2) + 4 + (j & 3); }
    return c;
}
template <int MODE> __device__ __forceinline__ void tr_item(const float* __restrict__ W, int N, bf16_t* __restrict__ WT, int Kd, LAS float* scr, int item, int lane, const float* __restrict__ gk = nullptr) {
    const int nblk = N / 32, kb = item / nblk, nb = item % nblk, k0 = 64 * kb, n0 = 32 * nb;
    const int c = lane & 7;
    f32x4 g0 = {1.f, 1.f, 1.f, 1.f}, g1 = {1.f, 1.f, 1.f, 1.f};
    if (gk) { g0 = *(const f32x4*)(gk + k0 + 8 * c); g1 = *(const f32x4*)(gk + k0 + 8 * c + 4); }
    float wv[32];
#pragma unroll
    for (int i = 0; i < 32; ++i) { const int kk = 2 * i + (lane >> 5); wv[i] = W[(size_t)(k0 + kk) * N + n0 + (lane & 31)]; }
#pragma unroll
    for (int i = 0; i < 32; ++i) { const int kk = 2 * i + (lane >> 5); scr[kk * 33 + (lane & 31)] = wv[i]; }
    LDS_WAIT(); asm volatile("" ::: "memory");
#pragma unroll
    for (int j = 0; j < 4; ++j) { const int n = (lane >> 3) + 8 * j; const LAS float* s = scr + (8 * c) * 33 + n;
        u32x4 o; o.x = pk2(s[0 * 33] * g0.x, s[1 * 33] * g0.y); o.y = pk2(s[2 * 33] * g0.z, s[3 * 33] * g0.w); o.z = pk2(s[4 * 33] * g1.x, s[5 * 33] * g1.y); o.w = pk2(s[6 * 33] * g1.z, s[7 * 33] * g1.w);
        *(GAS u32x4*)(WT + (size_t)wmap<MODE>(n0 + n) * Kd + k0 + 8 * c) = o; }
    LDS_WAIT(); asm volatile("" ::: "memory");
}
__device__ __forceinline__ void prep_row0(const float* __restrict__ xrow, bf16_t* __restrict__ orow, pg8::u64* __restrict__ ssp, int lane) {
    const GAS f32x4* xr = (const GAS f32x4*)xrow + lane;
    f32x4 v[8]; float s = 0.f;
#pragma unroll
    for (int j = 0; j < 8; ++j) { v[j] = xr[64 * j]; s += (v[j].x * v[j].x + v[j].y * v[j].y) + (v[j].z * v[j].z + v[j].w * v[j].w); }
    s = wave_sum(s, lane);
    if (lane == 0) *ssp = (pg8::u64)(s * pg8::SS_SCALE + 0.5f);
    GAS u32x2* o8 = (GAS u32x2*)orow + lane;
#pragma unroll
    for (int j = 0; j < 8; ++j) { u32x2 w; w.x = cvt_pk_bf16(v[j].x, v[j].y); w.y = cvt_pk_bf16(v[j].z, v[j].w); o8[64 * j] = w; }
}
__device__ __forceinline__ void final_row(const bf16_t* __restrict__ xrow, const float* __restrict__ gain, float* __restrict__ orow, int lane) {
    u32x4 w[4]; float s = 0.f; f32x4 v[4][2];
#pragma unroll
    for (int j = 0; j < 4; ++j) w[j] = *(const GAS u32x4*)(xrow + 8 * lane + 512 * j);
#pragma unroll
    for (int j = 0; j < 4; ++j) { v[j][0] = (f32x4){__uint_as_float(w[j].x << 16), __uint_as_float(w[j].x & 0xffff0000u), __uint_as_float(w[j].y << 16), __uint_as_float(w[j].y & 0xffff0000u)};
        v[j][1] = (f32x4){__uint_as_float(w[j].z << 16), __uint_as_float(w[j].z & 0xffff0000u), __uint_as_float(w[j].w << 16), __uint_as_float(w[j].w & 0xffff0000u)};
#pragma unroll
        for (int h = 0; h < 2; ++h) s += (v[j][h].x * v[j][h].x + v[j][h].y * v[j][h].y) + (v[j][h].z * v[j][h].z + v[j][h].w * v[j][h].w); }
    const float rstd = 1.f / sqrtf(wave_sum(s, lane) * (1.f / DM) + NORM_EPS);
#pragma unroll
    for (int j = 0; j < 4; ++j)
#pragma unroll
        for (int h = 0; h < 2; ++h) { const f32x4 g = *(const f32x4*)(gain + 8 * lane + 512 * j + 4 * h); *(GAS f32x4*)(orow + 8 * lane + 512 * j + 4 * h) = (v[j][h] * rstd) * g; }
}
__device__ __forceinline__ void sincos_d(double x, double& s, double& c) {
    const double q = __builtin_rint(x * 0.63661977236758134308);
    double y = __builtin_fma(-q, 1.57079632679489655800e+00, x); y = __builtin_fma(-q, 6.12323399573676603587e-17, y);
    const int qi = (int)q; const double y2 = y * y;
    const double sp = y * (1.0 + y2 * (-1.0 / 6.0 + y2 * (1.0 / 120.0 + y2 * (-1.0 / 5040.0 + y2 * (1.0 / 362880.0 + y2 * (-1.0 / 39916800.0 + y2 * (1.0 / 6227020800.0 + y2 * (-1.0 / 1307674368000.0))))))));
    const double cp = 1.0 + y2 * (-0.5 + y2 * (1.0 / 24.0 + y2 * (-1.0 / 720.0 + y2 * (1.0 / 40320.0 + y2 * (-1.0 / 3628800.0 + y2 * (1.0 / 479001600.0 + y2 * (-1.0 / 87178291200.0 + y2 * (1.0 / 20922789888000.0))))))));
    const int k = qi & 3;
    s = (k == 0) ? sp : (k == 1) ? cp : (k == 2) ? -sp : -cp;
    c = (k == 0) ? cp : (k == 1) ? -sp : (k == 2) ? -cp : sp;
}
__device__ __forceinline__ double inv_freq(int j) {
    const int a = j >> 3, b = j & 7;
    const double pa = (a == 0) ? 1.0 : (a == 1) ? 0.1 : (a == 2) ? 0.01 : 0.001;
    const double pb = (b == 0) ? 1.0 : (b == 1) ? 0.7498942093324559 : (b == 2) ? 0.5623413251903491 : (b == 3) ? 0.4216965034285822 : (b == 4) ? 0.31622776601683794
                    : (b == 5) ? 0.23713737056616552 : (b == 6) ? 0.1778279410038923 : 0.1333521432163324;
    return pa * pb;
}

struct Args { const float* in[16]; float* out; unsigned char* ws; };
typedef const __attribute__((address_space(4))) Args* KArgs;
__device__ __forceinline__ KArgs kargs() { auto p = __builtin_amdgcn_kernarg_segment_ptr(); asm volatile("" : "+s"(p)); return (KArgs)p; }
#define KA_IN(i) (kargs()->in[i])
#define KA_WS() (kargs()->ws)
#define KA_OUT() (kargs()->out)
__global__ void __launch_bounds__(NWAVES * 64, 2) fwd(Args args) {
    (void)args;
    extern __shared__ __attribute__((aligned(16))) unsigned char lds[];
    LAS unsigned char* const ldsl = (LAS unsigned char*)lds;
    const int wave0 = __builtin_amdgcn_readfirstlane(threadIdx.x >> 6);
    constexpr int G = NBLK; const int bx = blockIdx.x, vcu = (bx % 8) * (G / 8) + bx / 8;
    constexpr int NGW = G * NWAVES, NGT = G * NWAVES * 64;
#define IDS() int wave_ = wave0; asm volatile("" : "+s"(wave_)); const int lane = fresh_lane(), wave = wave_, tid = wave * 64 + lane; const int gw = vcu * NWAVES + wave, gt = vcu * (NWAVES * 64) + tid; (void)lane; (void)gw; (void)gt; (void)tid
    { IDS(); for (int u = tid; u < (LDS_BYTES - LDSCTL_OFF) / 4; u += NWAVES * 64) ((LAS unsigned*)(ldsl + LDSCTL_OFF))[u] = 0u; }
    __syncthreads();
    XcdBarrier bar0 = xcd_barrier_post((unsigned*)(KA_WS() + WS_CTL) + CW_BAR, (volatile LAS unsigned*)(ldsl + MISC_OFF) + 8);
    const unsigned bar_x = bar0.x;
    if (PROBE_CLASS != 0 && bx == 0 && wave0 == 0 && fresh_lane() == 0) { volatile LAS unsigned long long* pt_ = (volatile LAS unsigned long long*)(ldsl + MISC_OFF + 64); pt_[0] = __builtin_amdgcn_s_memrealtime(); pt_[1] = 0ull; }
#define GRID_BAR(label) do { XcdBarrier b_; b_.bar = (unsigned*)(KA_WS() + WS_CTL) + CW_BAR; b_.x = bar_x; b_.st = (volatile LAS unsigned*)(ldsl + MISC_OFF) + 8; b_.leader = (wave0 == 0) && (fresh_lane() == 0); \
        if (PROBE_CLASS != 0 && PROBE_MODE == 1) { __syncthreads(); if (bx == 0 && b_.leader) { volatile LAS unsigned long long* pt_ = (volatile LAS unsigned long long*)(ldsl + MISC_OFF + 64); pt_[0] = __builtin_amdgcn_s_memrealtime(); } } \
        xcd_barrier(b_); \
        if (PROBE_CLASS != 0 && bx == 0 && b_.leader) { volatile LAS unsigned long long* pt_ = (volatile LAS unsigned long long*)(ldsl + MISC_OFF + 64); const unsigned long long now_ = __builtin_amdgcn_s_memrealtime(); \
            if ((label) == PROBE_CLASS) pt_[1] += now_ - pt_[0]; pt_[0] = now_; } } while (0)
#define SCR() ((LAS float*)(ldsl + RING_OFF + wave * 16384))

    { IDS(); unsigned char* const ws = KA_WS(); float* const tabc = (float*)(ws + WS_ROPE_C); float* const tabs = (float*)(ws + WS_ROPE_S);
      for (int e = gt; e < SEQ_P * 32; e += NGT) { const int pos = e >> 5, j = e & 31; double s, c; sincos_d((double)pos * inv_freq(j), s, c); tabc[e] = (float)c; tabs[e] = (float)s; } }

    for (int layer = 0; layer < 4; ++layer) {
        const int lj = layer >> 1; const bool isB = (layer & 1) != 0;
        for (int rep = 0; rep < REP_THIN; ++rep)
        {
            constexpr int I_G = (DM / 64) * (DFF / 32), I_D = (DFF / 64) * (DM / 32), I_O = (DM / 64) * (DM / 32);
            if (!isB) {
                constexpr int I_QKV = (DM / 64) * (NQKV / 32);
                { IDS(); unsigned char* const ws = KA_WS(); const float* wqkv = KA_IN(5) + (size_t)lj * DM * NQKV;
                  const float* gmix = KA_IN(2) + layer * DM;
                  for (int it = gw; it < I_QKV; it += NGW) tr_item<0>(wqkv, NQKV, (bf16_t*)(ws + W_QKV), DM, SCR(), it, lane, gmix); }
                { IDS(); unsigned char* const ws = KA_WS(); const float* wo = KA_IN(6) + (size_t)lj * DM * DM;
                  for (int it = gw; it < I_O; it += NGW) tr_item<0>(wo, DM, (bf16_t*)(ws + W_O), DM, SCR(), it, lane); }
            } else {
                constexpr int I_A = (DM / 64) * (NA / 32), I_UQ = (QLR / 64) * (NQ / 32), I_UKV = (KVL / 64) * (NKV / 32);
                { IDS(); unsigned char* const ws = KA_WS(); const float* wa = KA_IN(7) + (size_t)lj * DM * NA;
                  const float* gmix = KA_IN(2) + layer * DM;
                  for (int it = gw; it < I_A; it += NGW) tr_item<4>(wa, NA, (bf16_t*)(ws + W_WA), DM, SCR(), it, lane, gmix);
                  pg8::u64* const lss = (pg8::u64*)(ws + WS_SS) + (size_t)(2 * layer - 2) * T_ALL; unsigned zq = 0u; asm volatile("" : "+v"(zq)); for (int e = gt; e < 2 * T_ALL; e += NGT) *(GAS u32x2*)(lss + e) = (u32x2){zq, zq}; }
                { IDS(); unsigned char* const ws = KA_WS(); const float* wuq = KA_IN(10) + (size_t)lj * QLR * NQ;
                  for (int it = gw; it < I_UQ; it += NGW) tr_item<3>(wuq, NQ, (bf16_t*)(ws + W_UQ), QLP, SCR(), it, lane, KA_IN(8) + lj * QLR);
                  unsigned zz = 0u; asm volatile("" : "+v"(zz));
                  for (int e = gt; e < NQ * 8; e += NGT) *(GAS u32x4*)((bf16_t*)(ws + W_UQ) + (size_t)(e >> 3) * QLP + QLR + (e & 7) * 8) = (u32x4){zz, zz, zz, zz}; }
                { IDS(); unsigned char* const ws = KA_WS(); const float* wukv = KA_IN(11) + (size_t)lj * KVL * NKV;
                  for (int it = gw; it < I_UKV; it += NGW) tr_item<0>(wukv, NKV, (bf16_t*)(ws + W_UKV), KVL, SCR(), it, lane, KA_IN(9) + lj * KVL); }
                { IDS(); unsigned char* const ws = KA_WS(); const float* wo = KA_IN(12) + (size_t)lj * DM * DM;
                  for (int it = gw; it < I_O; it += NGW) tr_item<0>(wo, DM, (bf16_t*)(ws + W_O), DM, SCR(), it, lane); }
            }
            { IDS(); unsigned char* const ws = KA_WS(); const float* wg = KA_IN(13) + (size_t)layer * DM * DFF;
              const float* gffn = KA_IN(3) + layer * DM;
              for (int it = gw; it < I_G; it += NGW) tr_item<1>(wg, DFF, (bf16_t*)(ws + W_GU), DM, SCR(), it, lane, gffn); }
            { IDS(); unsigned char* const ws = KA_WS(); const float* wu = KA_IN(14) + (size_t)layer * DM * DFF;
              const float* gffn = KA_IN(3) + layer * DM;
              for (int it = gw; it < I_G; it += NGW) tr_item<2>(wu, DFF, (bf16_t*)(ws + W_GU), DM, SCR(), it, lane, gffn); }
            { IDS(); unsigned char* const ws = KA_WS(); const float* wd = KA_IN(15) + (size_t)layer * DFF * DM;
              for (int it = gw; it < I_D; it += NGW) tr_item<0>(wd, DM, (bf16_t*)(ws + W_DN), DFF, SCR(), it, lane); }
            if (layer == 0) { IDS(); unsigned char* const ws = KA_WS(); bf16_t* const Hb = (bf16_t*)(ws + WS_H); pg8::u64* const ss0 = (pg8::u64*)(ws + WS_SS);
              const float* x_prompt = KA_IN(0); const float* x_sample = KA_IN(1);
              for (int m = gw; m < T_ALL; m += NGW) { const float* src = m < T_PROMPT ? x_prompt + (size_t)m * DM : x_sample + (size_t)(m - T_PROMPT) * DM; prep_row0(src, Hb + (size_t)m * DM, ss0 + m, lane); } }
        }
        GRID_BAR(PC_PREP);
        if (!isB) {
            for (int ch = 0; ch < NCHUNK; ++ch) {
                for (int rep = 0; rep < REP_QKV; ++rep)
                { IDS(); unsigned char* const ws = KA_WS();
                  pg8::Gemm g{(const bf16_t*)(ws + WS_H) + (size_t)ch * CHUNK * DM, (const bf16_t*)(ws + W_QKV), CHUNK, NQKV, DM}; pg8::StaticOrder S; S.init(CHUNK, NQKV, G, bx);
                  pg8::EpiBf16 E{(bf16_t*)(ws + S_QKV), NQKV, CHUNK, (const pg8::u64*)(ws + WS_SS) + (size_t)(2 * layer) * T_ALL + (size_t)ch * CHUNK}; pg8::gemm_phase<pg8::EpiBf16, pg8::StaticOrder>(ldsl + RING_OFF, g, S, E, wave0); }
                GRID_BAR(PC_QKV);
                { IDS(); unsigned char* const ws = KA_WS(); const bf16_t* const QKV = (const bf16_t*)(ws + S_QKV); bf16_t* const OG = (bf16_t*)(ws + S_OG); float* const LSE = (float*)(ws + S_LSE);
                  const int S_len = ch < 4 ? SEQ_P : SEQ_S, nseq = ch < 4 ? 1 : 2, NB = S_len / 64;
                  const int L2 = (NB / 16) < 8 ? (NB / 16) : 8, c01 = NH * (NB / 8), c2 = NH * (NB / L2), per_seq = 2 * c01 + c2, nitems = nseq * per_seq;
                  for (int rep = 0; rep < REP_DWA; ++rep)
                  for (int it = vcu; it < nitems; it += G) {
                      const int ir = nitems - 1 - it;
                      const int sq = ir / per_seq, r0 = ir % per_seq, g = r0 < c01 ? 0 : (r0 < 2 * c01 ? 1 : 2), r1 = r0 - g * c01;
                      const int dil = g == 0 ? 1 : (g == 1 ? 4 : 16), L = g == 2 ? L2 : 8, per_h = NB / L, h = r1 / per_h, j = r1 % per_h, per_c = (NB / dil) / L;
                      dwa::item(QKV, OG, LSE, sq * S_len, S_len, g, dil, j / per_c, (j % per_c) * L, L, h, (char*)lds + RING_OFF, wave0); } }
                GRID_BAR(PC_DWA);
                for (int rep = 0; rep < REP_THIN; ++rep)
                { IDS(); unsigned char* const ws = KA_WS(); const bf16_t* const OG = (const bf16_t*)(ws + S_OG); const float* const LSE = (const float*)(ws + S_LSE); bf16_t* const OA = (bf16_t*)(ws + S_OA);
                  for (int e = gt; e < CHUNK * (DM / 8); e += NGT) { const int row = e >> 8, c8 = e & 255, h = c8 >> 4;
                    const float l0 = LSE[(row * 3 + 0) * NH + h], l1 = LSE[(row * 3 + 1) * NH + h], l2 = LSE[(row * 3 + 2) * NH + h];
                    const float mx = fmaxf(l0, fmaxf(l1, l2)); float w0 = __builtin_amdgcn_exp2f(l0 - mx), w1 = __builtin_amdgcn_exp2f(l1 - mx), w2 = __builtin_amdgcn_exp2f(l2 - mx);
                    const float inv = 1.f / (w0 + w1 + w2); w0 *= inv; w1 *= inv; w2 *= inv;
                    const u32x4 a0 = *(const u32x4*)(OG + ((size_t)row * 3 + 0) * DM + c8 * 8), a1 = *(const u32x4*)(OG + ((size_t)row * 3 + 1) * DM + c8 * 8), a2 = *(const u32x4*)(OG + ((size_t)row * 3 + 2) * DM + c8 * 8);
                    u32x4 o;
#pragma unroll
                    for (int k = 0; k < 4; ++k) { const float lo = w0 * __uint_as_float(a0[k] << 16) + w1 * __uint_as_float(a1[k] << 16) + w2 * __uint_as_float(a2[k] << 16);
                        const float hi = w0 * __uint_as_float(a0[k] & 0xffff0000u) + w1 * __uint_as_float(a1[k] & 0xffff0000u) + w2 * __uint_as_float(a2[k] & 0xffff0000u); o[k] = cvt_pk_bf16(lo, hi); }
                    *(u32x4*)(OA + ((size_t)ch * CHUNK + row) * DM + c8 * 8) = o; } }
                if (PROBE_CLASS != 0 && ch + 1 < NCHUNK) GRID_BAR(PC_MERGE);
            }
        } else {
            { IDS(); unsigned char* const ws = KA_WS();
              pg8::Gemm g{(const bf16_t*)(ws + WS_H), (const bf16_t*)(ws + W_WA), T_ALL, NA, DM}; pg8::StaticOrder S; S.init(T_ALL, NA, G, bx);
              pg8::u64* const lss = (pg8::u64*)(ws + WS_SS) + (size_t)(2 * layer - 2) * T_ALL;
              pg8::EpiLat E{(bf16_t*)(ws + S_CQ), (bf16_t*)(ws + S_CKV), (bf16_t*)(ws + S_KR), (const pg8::u64*)(ws + WS_SS) + (size_t)(2 * layer) * T_ALL, lss, lss + T_ALL, (const float*)(ws + WS_ROPE_C), (const float*)(ws + WS_ROPE_S)};
              pg8::gemm_phase<pg8::EpiLat, pg8::StaticOrder>(ldsl + RING_OFF, g, S, E, wave0); }
            GRID_BAR(PC_WA);
            { IDS(); unsigned char* const ws = KA_WS();
              pg8::Gemm g{(const bf16_t*)(ws + S_CQ), (const bf16_t*)(ws + W_UQ), T_ALL, NQ, QLP}; pg8::StaticOrder S; S.init(T_ALL, NQ, G, bx);
              pg8::EpiQRope E{(bf16_t*)(ws + S_Q), NQ, (const float*)(ws + WS_ROPE_C), (const float*)(ws + WS_ROPE_S), 0, (const pg8::u64*)(ws + WS_SS) + (size_t)(2 * layer - 2) * T_ALL, 1.0f / QLR}; pg8::gemm_phase<pg8::EpiQRope, pg8::StaticOrder>(ldsl + RING_OFF, g, S, E, wave0); }
            { IDS(); unsigned char* const ws = KA_WS();
              pg8::Gemm g{(const bf16_t*)(ws + S_CKV), (const bf16_t*)(ws + W_UKV), T_ALL, NKV, KVL}; pg8::StaticOrder S; S.init(T_ALL, NKV, G, bx);
              pg8::EpiBf16 E{(bf16_t*)(ws + S_KV), NKV, 0, (const pg8::u64*)(ws + WS_SS) + (size_t)(2 * layer - 1) * T_ALL, 1.0f / KVL}; pg8::gemm_phase<pg8::EpiBf16, pg8::StaticOrder>(ldsl + RING_OFF, g, S, E, wave0); }
            GRID_BAR(PC_QKVB);
            {
                IDS(); unsigned char* const ws = KA_WS(); const bf16_t* const Qb = (const bf16_t*)(ws + S_Q); const bf16_t* const KVb = (const bf16_t*)(ws + S_KV); const bf16_t* const KR = (const bf16_t*)(ws + S_KR); bf16_t* const Ob = (bf16_t*)(ws + S_OB);
                for (int rep = 0; rep < REP_MLA; ++rep)
                for (int id = vcu; id < 2560; id += G) {
                    int seqrow0, seqlen, h, qb;
                    if (id < 2048) { const int pair = id >> 5; qb = id & 31; h = pair & 15; seqrow0 = (pair >> 4) * SEQ_P; seqlen = SEQ_P; }
                    else { const int i2 = id - 2048, pair = i2 >> 4; qb = i2 & 15; h = pair & 15; seqrow0 = T_PROMPT + (pair >> 4) * SEQ_S; seqlen = SEQ_S; }
                    mla::attn_unit(Qb + (size_t)(seqrow0 + qb * 256) * NQ + h * 192, KVb + (size_t)seqrow0 * NKV + h * 256, KR + (size_t)seqrow0 * 64, KVb + (size_t)seqrow0 * NKV + h * 256 + 128,
                                   Ob + (size_t)(seqrow0 + qb * 256) * DM + h * 128, seqlen, (char*)lds + RING_OFF, wave0); }
            }
        }
        GRID_BAR((isB ? PC_MLA : PC_MERGE));
        { IDS(); unsigned char* const ws = KA_WS();
          pg8::Gemm g{(const bf16_t*)(ws + (isB ? S_OB : S_OA)), (const bf16_t*)(ws + W_O), T_ALL, DM, DM}; pg8::StaticOrder S; S.init(T_ALL, DM, G, bx);
          pg8::EpiRes E{(bf16_t*)(ws + WS_H), DM, (pg8::u64*)(ws + WS_SS) + (size_t)(2 * layer + 1) * T_ALL};
          pg8::gemm_phase<pg8::EpiRes, pg8::StaticOrder, true, false>(ldsl + RING_OFF, g, S, E, wave0); }
        GRID_BAR(PC_WO);
        for (int rep = 0; rep < REP_FFN; ++rep)
        { IDS(); unsigned char* const ws = KA_WS();
          pg8::Gemm g{(const bf16_t*)(ws + WS_H), (const bf16_t*)(ws + W_GU), T_ALL, 2 * DFF, DM}; pg8::StaticOrder S; S.init(T_ALL, 2 * DFF, G, bx);
          pg8::EpiSwiGLU E{(bf16_t*)(ws + S_ACT), DFF, (const pg8::u64*)(ws + WS_SS) + (size_t)(2 * layer + 1) * T_ALL}; pg8::gemm_phase<pg8::EpiSwiGLU, pg8::StaticOrder>(ldsl + RING_OFF, g, S, E, wave0); }
        GRID_BAR(PC_GU);
        { IDS(); unsigned char* const ws = KA_WS();
          pg8::Gemm g{(const bf16_t*)(ws + S_ACT), (const bf16_t*)(ws + W_DN), T_ALL, DM, DFF}; pg8::StaticOrder S; S.init(T_ALL, DM, G, bx);
          pg8::EpiRes E{(bf16_t*)(ws + WS_H), DM, layer < 3 ? (pg8::u64*)(ws + WS_SS) + (size_t)(2 * layer + 2) * T_ALL : nullptr};
          pg8::gemm_phase<pg8::EpiRes, pg8::StaticOrder, true, false>(ldsl + RING_OFF, g, S, E, wave0); }
        GRID_BAR(PC_DOWN);
    }
    { IDS(); float* const out = KA_OUT(); const float* norm_final = KA_IN(4); const bf16_t* const Hb = (const bf16_t*)(KA_WS() + WS_H);
      const unsigned dead = __hip_atomic_load((unsigned*)(KA_WS() + WS_CTL) + CW_BAR + XB_TMO, RLX_AGENT);
      for (int m = gw; m < T_ALL; m += NGW) { final_row(Hb + (size_t)m * DM, norm_final, out + (size_t)m * DM, lane);
          if (dead) { const float qn = __builtin_nanf(""); ((GAS f32x4*)(out + (size_t)m * DM))[lane] = (f32x4){qn, qn, qn, qn}; } } }
    if (PROBE_CLASS != 0 && bx == 0 && wave0 == 0 && fresh_lane() == 0) {
        volatile LAS unsigned long long* pt_ = (volatile LAS unsigned long long*)(ldsl + MISC_OFF + 64); const unsigned long long t0_ = __builtin_amdgcn_s_memrealtime(), wait_ = (unsigned long long)PROBE_AMP * pt_[1];
        while (__builtin_amdgcn_s_memrealtime() - t0_ < wait_) __builtin_amdgcn_s_sleep(32); }
}

extern "C" void kernel_launch(void* const* d_in, const int* in_sizes, int n_in, void* d_out, int out_size, void* d_ws, size_t ws_size, hipStream_t stream) {
    static int grid = 0;
    if (grid == 0) {
        if (n_in != 16 || out_size != T_ALL * DM || ws_size < WS_END) { fprintf(stderr, "kernel_launch: shape mismatch (n_in %d out %d ws %zu, need ws >= %zu)\n", n_in, out_size, ws_size, (size_t)WS_END); grid = -1; return; }
        int dev = 0, cus = 0, per_cu = 0;
        if (hipGetDevice(&dev) != hipSuccess || hipDeviceGetAttribute(&cus, hipDeviceAttributeMultiprocessorCount, dev) != hipSuccess) { grid = -1; return; }
        if (hipFuncSetAttribute((const void*)fwd, hipFuncAttributeMaxDynamicSharedMemorySize, LDS_BYTES) != hipSuccess) { fprintf(stderr, "kernel_launch: hipFuncSetAttribute failed\n"); grid = -1; return; }
        if (hipOccupancyMaxActiveBlocksPerMultiprocessor(&per_cu, (const void*)fwd, NWAVES * 64, LDS_BYTES) != hipSuccess || per_cu < 1)
            fprintf(stderr, "kernel_launch: occupancy query reports %d workgroups per CU\n", per_cu);
        (void)hipGetLastError();
        if (cus < NBLK) { fprintf(stderr, "kernel_launch: built for %d CUs, device has %d\n", NBLK, cus); grid = -1; return; }
        grid = NBLK;
    }
    if (grid < 0) return;
    if (hipMemsetAsync((char*)d_ws + WS_CTL, 0, CTL_ZERO_BYTES, stream) != hipSuccess) { fprintf(stderr, "kernel_launch: memset failed\n"); return; }
    Args a{};
    for (int i = 0; i < 16; ++i) a.in[i] = (const float*)d_in[i];
    a.out = (float*)d_out; a.ws = (unsigned char*)d_ws;
    hipLaunchKernelGGL(fwd, dim3(grid), dim3(NWAVES * 64), LDS_BYTES, stream, a);
    const hipError_t le = hipPeekAtLastError();
    if (le != hipSuccess) fprintf(stderr, "kernel_launch: launch failed: %s\n", hipGetErrorName(le));
}
```
